# Optimizing an MI355X kernel written in HIP

```python
import jax, jax.numpy as jnp
from jax import lax
import numpy as np

D_MODEL = 1024
BATCH = 32
SEQ = 2048
DEPTH = 1

CTX_LEN = 256
GRID_W = 64
D_MIX = D_MODEL
RET_HEADS = 4
RET_DK = 64
RET_DV = 128
D_RET_QK = RET_HEADS * RET_DK
D_RET_V = RET_HEADS * RET_DV
FOURIER_GROUPS = 4
FOURIER_CH = 128
D_FOURIER = FOURIER_GROUPS * FOURIER_CH
D_IN = 2 * D_RET_QK + 3 * D_RET_V + D_FOURIER
D_FF = 2816
RET_CHUNK = 128
ROPE_BASE = 10000.0
N_MOD = 9
EPS = 1e-6

kernel_name = "hybrid_retention_fourier_macaron_dit_block"


def _rms_norm(x, g):
    xf = x.astype(jnp.float32)
    y = xf * lax.rsqrt(jnp.mean(xf * xf, axis=-1, keepdims=True) + EPS)
    return (y * g.astype(jnp.float32)).astype(x.dtype)


def _modulate(x, shift, scale):
    return x * (1.0 + scale) + shift


def _swiglu(x, w13, w2):
    a, b = jnp.split(x @ w13, 2, axis=-1)
    return (jax.nn.silu(a) * b) @ w2


def _split_heads(t, dh):
    b, n, _ = t.shape
    return t.reshape(b, n, -1, dh).transpose(0, 2, 1, 3)


def _rope_tables(rows, cols):
    n_freq = RET_DK // 4
    inv_freq = ROPE_BASE ** (-jnp.arange(n_freq, dtype=jnp.float32) / n_freq)
    ang = jnp.concatenate([rows.astype(jnp.float32)[:, None] * inv_freq,
                           cols.astype(jnp.float32)[:, None] * inv_freq], axis=-1)
    return jnp.cos(ang), jnp.sin(ang)


def _rope(t, cos, sin):
    half = RET_DK // 2
    t1, t2 = t[..., :half], t[..., half:]
    return jnp.concatenate([t1 * cos - t2 * sin, t2 * cos + t1 * sin], axis=-1)


def _chunk(t):
    b, h, n, d = t.shape
    return t.reshape(b, h, n // RET_CHUNK, RET_CHUNK, d)


def _decay_terms(lg):
    pos = jnp.arange(RET_CHUNK, dtype=jnp.float32)
    diff = pos[:, None] - pos[None, :]
    lower = diff >= 0
    d_intra = jnp.where(lower[None], jnp.exp(jnp.maximum(diff, 0.0)[None] * lg[:, None, None]), 0.0)
    xi = jnp.exp((pos[None] + 1.0) * lg[:, None])
    zeta = jnp.exp((RET_CHUNK - 1.0 - pos[None]) * lg[:, None])
    decay_chunk = jnp.exp(RET_CHUNK * lg)
    return d_intra, xi, zeta, decay_chunk


def _retention_states(k, v, lg, s0):
    _, _, zeta, decay_chunk = _decay_terms(lg)
    u = jnp.einsum('bhncd,hc,bhnce->nbhde', _chunk(k), zeta, _chunk(v))

    def step(s, u_i):
        return decay_chunk[None, :, None, None] * s + u_i, s

    final, prev = lax.scan(step, s0, u)
    return prev, final


def _retention_outputs(q, k, v, lg, prev):
    d_intra, xi, _, _ = _decay_terms(lg)
    qc, kc, vc = _chunk(q), _chunk(k), _chunk(v)
    scores = jnp.einsum('bhncd,bhnmd->bhncm', qc, kc) * d_intra[None, :, None]
    o = (jnp.einsum('bhncm,bhnme->bhnce', scores, vc)
         + jnp.einsum('bhncd,nbhde->bhnce', qc, prev) * xi[None, :, None, :, None])
    b, h, nc, cl, dv = o.shape
    return o.reshape(b, h, nc * cl, dv)


def _flip(t):
    return jnp.flip(t, axis=2)


def _group_norm(o):
    mu = jnp.mean(o, axis=-1, keepdims=True)
    var = jnp.mean(jnp.square(o - mu), axis=-1, keepdims=True)
    y = (o - mu) * lax.rsqrt(var + EPS)
    b, h, n, dv = y.shape
    return y.transpose(0, 2, 1, 3).reshape(b, n, h * dv)


def _gated_sum(o_f, o_b, g_f, g_b):
    y = (jax.nn.silu(g_f.astype(jnp.float32)) * _group_norm(o_f)
         + jax.nn.silu(g_b.astype(jnp.float32)) * _group_norm(o_b))
    return y.astype(g_f.dtype)


def _fourier_mix(u):
    b, n, _ = u.shape
    ug = u.astype(jnp.float32).reshape(b, n, FOURIER_GROUPS, FOURIER_CH)
    f = jnp.fft.fft2(ug, axes=(1, 3), norm="ortho").real
    return f.reshape(b, n, D_FOURIER).astype(u.dtype)


def _split_projection(p):
    i1 = D_RET_QK
    i2 = i1 + D_RET_QK
    i3 = i2 + D_RET_V
    i4 = i3 + D_RET_V
    i5 = i4 + D_RET_V
    return p[..., :i1], p[..., i1:i2], p[..., i2:i3], p[..., i3:i4], p[..., i4:i5], p[..., i5:]


def _retention_heads(q, k, v, rope=None):
    qh = _split_heads(q, RET_DK).astype(jnp.float32)
    kh = _split_heads(k, RET_DK).astype(jnp.float32) * (RET_DK ** -0.5)
    vh = _split_heads(v, RET_DV).astype(jnp.float32)
    if rope is not None:
        cos, sin = rope
        qh, kh = _rope(qh, cos, sin), _rope(kh, cos, sin)
    return qh, kh, vh


def setup_inputs(seed: int = 0) -> dict:
    key = jax.random.key(seed)
    ks = jax.random.split(key, 18)
    f32 = jnp.float32
    nrm = lambda k, shape, s: (jax.random.normal(k, shape, f32) * s)
    gain = lambda k, shape: 1.0 + 0.02 * jax.random.normal(k, shape, f32)
    base_decay = jnp.log(1.0 - 2.0 ** (-5.0 - jnp.arange(RET_HEADS, dtype=f32)))
    ret_log_decay = base_decay[None, None, :] * (1.0 + 0.05 * jax.random.normal(ks[11], (DEPTH, 2, RET_HEADS), f32))
    return {
        "x": nrm(ks[0], (BATCH, SEQ, D_MODEL), 1.0),
        "c": nrm(ks[1], (BATCH, D_MODEL), 1.0),
        "ctx": nrm(ks[2], (BATCH, CTX_LEN, D_MODEL), 1.0),
        "c_ctx": nrm(ks[3], (D_MODEL,), 1.0),
        "w_mod": nrm(ks[4], (DEPTH, D_MODEL, N_MOD * D_MODEL), 0.5 * D_MODEL ** -0.5),
        "b_mod": nrm(ks[5], (DEPTH, N_MOD * D_MODEL), 0.02),
        "norm_ffn1": gain(ks[6], (DEPTH, D_MODEL)),
        "w13_ffn1": nrm(ks[7], (DEPTH, D_MODEL, 2 * D_FF), D_MODEL ** -0.5),
        "w2_ffn1": nrm(ks[8], (DEPTH, D_FF, D_MODEL), D_FF ** -0.5),
        "norm_mix": gain(ks[9], (DEPTH, D_MODEL)),
        "w_in": nrm(ks[10], (DEPTH, D_MODEL, D_IN), D_MODEL ** -0.5),
        "ret_log_decay": ret_log_decay,
        "w_out": nrm(ks[12], (DEPTH, D_MIX, D_MODEL), D_MIX ** -0.5),
        "norm_ffn2": gain(ks[13], (DEPTH, D_MODEL)),
        "w13_ffn2": nrm(ks[14], (DEPTH, D_MODEL, 2 * D_FF), D_MODEL ** -0.5),
        "w2_ffn2": nrm(ks[15], (DEPTH, D_FF, D_MODEL), D_FF ** -0.5),
        "norm_final": gain(ks[16], (D_MODEL,)),
    }


def reference(x, c, ctx, c_ctx, w_mod, b_mod, norm_ffn1, w13_ffn1, w2_ffn1, norm_mix, w_in,
              ret_log_decay, w_out, norm_ffn2, w13_ffn2, w2_ffn2, norm_final):
    b, n, _ = x.shape
    n_rows = n // GRID_W
    rows = jnp.repeat(jnp.arange(n_rows), GRID_W)
    cols = jnp.tile(jnp.arange(GRID_W), n_rows)
    rope = _rope_tables(rows, cols)
    cond = jax.nn.silu(c)
    cond_ctx = jax.nn.silu(c_ctx)
    h, hc = x, ctx
    for l in range(DEPTH):
        last = l == DEPTH - 1
        m = jnp.split((cond @ w_mod[l] + b_mod[l])[:, None, :], N_MOD, axis=-1)
        mc = jnp.split((cond_ctx @ w_mod[l] + b_mod[l])[None, None, :], N_MOD, axis=-1)

        h = h + 0.5 * m[2] * _swiglu(_modulate(_rms_norm(h, norm_ffn1[l]), m[0], m[1]), w13_ffn1[l], w2_ffn1[l])
        hc = hc + 0.5 * mc[2] * _swiglu(_modulate(_rms_norm(hc, norm_ffn1[l]), mc[0], mc[1]), w13_ffn1[l], w2_ffn1[l])

        xn = _modulate(_rms_norm(h, norm_mix[l]), m[3], m[4])
        xcn = _modulate(_rms_norm(hc, norm_mix[l]), mc[3], mc[4])
        q_x, k_x, v_x, gf_x, gb_x, fu_x = _split_projection(xn @ w_in[l])
        q_c, k_c, v_c, gf_c, gb_c, fu_c = _split_projection(xcn @ w_in[l])
        qx, kx, vx = _retention_heads(q_x, k_x, v_x, rope)
        qc, kc, vc = _retention_heads(q_c, k_c, v_c)
        lg = ret_log_decay[l].astype(jnp.float32)
        lg_f, lg_b = lg[0], lg[1]
        zeros = jnp.zeros((b, RET_HEADS, RET_DK, RET_DV), jnp.float32)

        prev_cf, s_cf = _retention_states(kc, vc, lg_f, zeros)
        prev_cb, s_cb = _retention_states(_flip(kc), _flip(vc), lg_b, zeros)
        prev_lf, _ = _retention_states(kx, vx, lg_f, s_cf)
        o_lf = _retention_outputs(qx, kx, vx, lg_f, prev_lf)
        prev_lb, _ = _retention_states(_flip(kx), _flip(vx), lg_b, s_cb)
        o_lb = _flip(_retention_outputs(_flip(qx), _flip(kx), _flip(vx), lg_b, prev_lb))
        ret_x = _gated_sum(o_lf, o_lb, gf_x, gb_x)
        four_x = _fourier_mix(fu_x)
        h = h + m[5] * (jnp.concatenate([ret_x, four_x], axis=-1) @ w_out[l])

        if not last:
            o_cf = _retention_outputs(qc, kc, vc, lg_f, prev_cf)
            o_cb = _flip(_retention_outputs(_flip(qc), _flip(kc), _flip(vc), lg_b, prev_cb))
            ret_c = _gated_sum(o_cf, o_cb, gf_c, gb_c)
            four_c = _fourier_mix(fu_c)
            hc = hc + mc[5] * (jnp.concatenate([ret_c, four_c], axis=-1) @ w_out[l])

        h = h + 0.5 * m[8] * _swiglu(_modulate(_rms_norm(h, norm_ffn2[l]), m[6], m[7]), w13_ffn2[l], w2_ffn2[l])
        if not last:
            hc = hc + 0.5 * mc[8] * _swiglu(_modulate(_rms_norm(hc, norm_ffn2[l]), mc[6], mc[7]), w13_ffn2[l], w2_ffn2[l])

    return _rms_norm(h, norm_final)
```

```cpp
#include <hip/hip_runtime.h>
#include <hip/hip_cooperative_groups.h>
#include <cstdio>
namespace cg = cooperative_groups;

#define LAS __attribute__((address_space(3)))
typedef unsigned short bf16_t;
typedef short bf16x8 __attribute__((ext_vector_type(8)));
typedef short bf16x4 __attribute__((ext_vector_type(4)));
typedef float f32x4 __attribute__((ext_vector_type(4)));
typedef unsigned u32x4 __attribute__((ext_vector_type(4)));
typedef unsigned u32x2 __attribute__((ext_vector_type(2)));

constexpr int MX = 65536, MC = 8192, MT = MX + MC, DM = 1024, DFF = 2816, NMOD = 9216;
constexpr int PW = 1536;
constexpr int CATW = 1536;

constexpr size_t SZ_WB13 = (size_t)5632 * 1024 * 2, SZ_WB2 = (size_t)1024 * 2816 * 2;
constexpr size_t OFF_WB13_1 = 0;
constexpr size_t OFF_WB2_1 = OFF_WB13_1 + SZ_WB13;
constexpr size_t OFF_WB13_2 = OFF_WB2_1 + SZ_WB2;
constexpr size_t OFF_WB2_2 = OFF_WB13_2 + SZ_WB13;
constexpr size_t OFF_WBIN = OFF_WB2_2 + SZ_WB2;
constexpr size_t OFF_WSW = OFF_WBIN + (size_t)1536 * 1024 * 2;
constexpr size_t OFF_WOUT3 = OFF_WSW + (size_t)1792 * 1024 * 2;
constexpr size_t OFF_TT = OFF_WOUT3 + (size_t)1024 * 1536 * 2;
constexpr size_t OFF_MOD = OFF_TT + (size_t)2048 * 2048 * 2;
constexpr size_t OFF_ROPE = OFF_MOD + (size_t)33 * 9216 * 4;
constexpr size_t OFF_YCH = OFF_ROPE + 16384;
constexpr size_t OFF_BAR = OFF_YCH + 65536;
constexpr size_t OFF_A = (size_t)80 << 20;
constexpr size_t SZ_A = (size_t)MX * CATW * 2;
constexpr size_t OFF_H = OFF_A + SZ_A;
constexpr size_t SZ_H = (size_t)MT * DFF * 2;
constexpr size_t OFF_P = OFF_H;
constexpr size_t OFF_YT = OFF_P + (size_t)MX * PW * 2;
constexpr size_t OFF_A2E = OFF_YT + (size_t)16384 * 2048 * 2;
constexpr size_t OFF_A2O = OFF_A2E + (size_t)32768 * 1024 * 2;
constexpr size_t OFF_HC = OFF_H + SZ_H;
constexpr size_t OFF_KTZ = OFF_HC + (size_t)MC * DM * 4;
constexpr size_t OFF_VT = OFF_KTZ + (size_t)2 * 256 * MX * 2;
constexpr size_t OFF_KTZC = OFF_VT + (size_t)512 * MX * 2;
constexpr size_t OFF_VTC = OFF_KTZC + (size_t)2 * 256 * MC * 2;
constexpr size_t OFF_H2B = OFF_KTZ;
constexpr size_t WS_END = OFF_VTC + (size_t)512 * MC * 2;
static_assert(OFF_BAR + 3456 * 4 <= OFF_A, "weights region overflow");
static_assert(OFF_A2O + (size_t)32768 * 1024 * 2 <= OFF_HC, "mix buffers overflow H region");

constexpr int XCD_BAR_WORDS_C = 3456;
constexpr int LDS_BYTES = 131072 + 16;

struct Params {
    const float *x, *c, *ctx, *c_ctx, *w_mod, *b_mod, *norm_ffn1, *w13_1, *w2_1, *norm_mix, *w_in, *ret_log_decay, *w_out, *norm_ffn2, *w13_2, *w2_2, *norm_final;
    float* out; unsigned char* ws;
};

__device__ __forceinline__ unsigned cvt_pk_bf16(float lo, float hi) { unsigned r; asm volatile("v_cvt_pk_bf16_f32 %0, %1, %2" : "=v"(r) : "v"(lo), "v"(hi)); return r; }
__device__ __forceinline__ float bf_lo(unsigned u) { return __uint_as_float(u << 16); }
__device__ __forceinline__ float bf_hi(unsigned u) { return __uint_as_float(u & 0xffff0000u); }
__device__ __forceinline__ float silu_f(float a) { return a * __builtin_amdgcn_rcpf(1.0f + __expf(-a)); }

namespace pg8 {
constexpr int BM = 256, BK = 64, HALF = 128, HTB = HALF * BK * 2, STAGE_BYTES = 8 * HTB, NXCD = 8, WGM = 8;
__device__ __forceinline__ int lds_byte(int r, int c) { const int st = (r >> 4) * 2 + (c >> 5), rr = r & 15, cc = c & 31, ob = rr * 64 + cc * 2; return st * 1024 + (ob ^ (((ob >> 9) & 1) << 5)); }
__device__ __forceinline__ void stage_rc(int b, int& R, int& C) { const int st = b / 1024, sb = b % 1024, swz = sb ^ (((sb >> 9) & 1) << 5); R = (st >> 1) * 16 + swz / 64; C = (st & 1) * 32 + (swz % 64) / 2; }
__device__ __forceinline__ int perm32(int rho) { const int n = rho >> 4, i = rho & 15; return 8 * (i >> 2) + 4 * n + (i & 3); }
struct Unit { int pm, pn; };
struct Gemm { const bf16_t* A; const bf16_t* Bt; int M, N, K; };
struct StaticOrder {
    int nM, nN, nwg, G, c, rev;
    __device__ void init(int M, int N, int G_, int c_, int rev_ = 0) { nM = M / BM; nN = N / BM; nwg = nM * nN; G = G_; c = c_; rev = rev_; }
    __device__ bool next(int i, Unit& u) const {
        const long L = (long)i * G + c; if (L >= nwg) return false;
        int wgid = rev ? (int)(nwg - 1 - L) : (int)L; { const int q = nwg / NXCD, r = nwg % NXCD, xcd = wgid % NXCD, off = wgid / NXCD; wgid = (xcd < r ? xcd * (q + 1) : r * (q + 1) + (xcd - r) * q) + off; }
        const int nig = WGM * nN, gid = wgid / nig, fm = gid * WGM, gsz = (nM - fm) < WGM ? (nM - fm) : WGM;
        u.pm = fm + ((wgid % nig) % gsz); u.pn = (wgid % nig) / gsz; return true;
    }
};

template <class Epi, class Sched>
__device__ __forceinline__ void gemm_phase(LAS unsigned char* lds, const Gemm g, const Sched& S, const Epi& E) {
    int tid_ = threadIdx.x; asm volatile("" : "+v"(tid_));
    const int tid = tid_, wid = __builtin_amdgcn_readfirstlane(tid >> 6), lane = tid & 63, wr = wid >> 2, wc = wid & 3, fr = lane & 15, fq = lane >> 4;
    const int K = g.K, nt = K / BK;
    unsigned voffA[2], voffB[2];
#pragma unroll
    for (int i = 0; i < 2; ++i) { int R, C; stage_rc(tid * 16 + i * 8192, R, C); const int Rb = Epi::PERM ? ((R & ~31) + perm32(R & 31)) : R;
        voffA[i] = (unsigned)(R * K + C) * 2u; voffB[i] = (unsigned)(Rb * K + C) * 2u; }
    const size_t kstep = (size_t)(BK * 2);
    const size_t hstep = (size_t)HALF * K * 2;
    const size_t tstep = 2 * hstep;
    const unsigned ldsw = (unsigned)wid * 1024u;
    const int aoff = lds_byte(wr * 64 + fr, fq * 8), boff = lds_byte(wc * 32 + fr, fq * 8);
#define PG8_SA(b, h) (((b) * 2 + (h)) * HTB)
#define PG8_SB(b, h) ((4 + (b) * 2 + (h)) * HTB)
#define PG8_STAGE(bufoff, gbase, voff) do { _Pragma("unroll") for (int _i = 0; _i < 2; ++_i) \
        __builtin_amdgcn_global_load_lds((const unsigned*)((const char*)(gbase) + (voff)[_i]), (LAS unsigned*)(lds + (bufoff) + ldsw + _i * 8192), 16, 0, 0); } while (0)
#define PG8_LDA(dst, b, h) do { _Pragma("unroll") for (int m = 0; m < 4; ++m) _Pragma("unroll") for (int k = 0; k < 2; ++k) dst[m][k] = *(const LAS bf16x8*)(lds + PG8_SA(b, h) + aoff + m * 2048 + k * 1024); } while (0)
#define PG8_LDB(dst, b, h) do { _Pragma("unroll") for (int n = 0; n < 2; ++n) _Pragma("unroll") for (int k = 0; k < 2; ++k) dst[n][k] = *(const LAS bf16x8*)(lds + PG8_SB(b, h) + boff + n * 2048 + k * 1024); } while (0)
#define PG8_MMA(ai, bj, At, Bt) do { __builtin_amdgcn_s_setprio(1); _Pragma("unroll") for (int m = 0; m < 4; ++m) _Pragma("unroll") for (int n = 0; n < 2; ++n) _Pragma("unroll") for (int k = 0; k < 2; ++k) \
        acc[ai][bj][m][n] = __builtin_amdgcn_mfma_f32_16x16x32_bf16(Bt[n][k], At[m][k], acc[ai][bj][m][n], 0, 0, 0); __builtin_amdgcn_s_setprio(0); } while (0)
#define PG8_WAIT_V(n) asm volatile("s_waitcnt vmcnt(" #n ")" ::: "memory")
#define PG8_WAIT_L(n) asm volatile("s_waitcnt lgkmcnt(" #n ")" ::: "memory")
#define PG8_BAR __builtin_amdgcn_s_barrier()
#define PG8_SCHED __builtin_amdgcn_sched_barrier(0)
    Unit cur, nxt; int ui = 0;
    if (!S.next(0, cur)) return;
    f32x4 acc[2][2][4][2];
#pragma unroll
    for (int a = 0; a < 2; ++a)
#pragma unroll
        for (int b = 0; b < 2; ++b)
#pragma unroll
            for (int m = 0; m < 4; ++m)
#pragma unroll
                for (int n = 0; n < 2; ++n) acc[a][b][m][n] = (f32x4){0.f, 0.f, 0.f, 0.f};
    bf16x8 At[4][2], B0[2][2], B1[2][2];
    const char* cA = (const char*)g.A + (size_t)cur.pm * tstep; const char* cB = (const char*)g.Bt + (size_t)cur.pn * tstep;
    PG8_STAGE(PG8_SB(0, 0), cB, voffB); PG8_STAGE(PG8_SA(0, 0), cA, voffA); PG8_STAGE(PG8_SB(0, 1), cB + hstep, voffB); PG8_STAGE(PG8_SA(0, 1), cA + hstep, voffA);
    if (wr == 1) PG8_BAR;
    PG8_WAIT_V(4); PG8_BAR;
    PG8_STAGE(PG8_SB(1, 0), cB + kstep, voffB); PG8_STAGE(PG8_SA(1, 0), cA + kstep, voffA); PG8_STAGE(PG8_SB(1, 1), cB + hstep + kstep, voffB);
    PG8_WAIT_V(6); PG8_BAR;
    for (;;) {
        const bool has_next = S.next(ui + 1, nxt);
        const char* nA = has_next ? (const char*)g.A + (size_t)nxt.pm * tstep : cA; const char* nB = has_next ? (const char*)g.Bt + (size_t)nxt.pn * tstep : cB;
        for (int t = 0; t < nt; t += 2) {
            const bool last = (t == nt - 2);
            const char* a1 = cA + (size_t)(t + 1) * kstep;
            const char* a2 = last ? nA : cA + (size_t)(t + 2) * kstep; const char* b2 = last ? nB : cB + (size_t)(t + 2) * kstep;
            const char* a3 = a2 + kstep; const char* b3 = b2 + kstep;
            PG8_LDB(B0, 0, 0); PG8_SCHED; PG8_LDA(At, 0, 0); PG8_STAGE(PG8_SA(1, 1), a1 + hstep, voffA);
            PG8_WAIT_L(8); PG8_BAR; PG8_WAIT_L(0); PG8_MMA(0, 0, At, B0); PG8_BAR; PG8_SCHED;
            PG8_LDB(B1, 0, 1); PG8_STAGE(PG8_SB(0, 0), b2, voffB);
            PG8_BAR; PG8_WAIT_L(0); PG8_MMA(0, 1, At, B1); PG8_BAR;
            PG8_LDA(At, 0, 1); PG8_STAGE(PG8_SA(0, 0), a2, voffA);
            PG8_BAR; PG8_WAIT_L(0); PG8_MMA(1, 0, At, B0); PG8_BAR; PG8_SCHED;
            PG8_STAGE(PG8_SB(0, 1), b2 + hstep, voffB);
            PG8_WAIT_V(6); PG8_BAR; PG8_MMA(1, 1, At, B1); PG8_BAR;
            PG8_LDB(B0, 1, 0); PG8_SCHED; PG8_LDA(At, 1, 0); PG8_STAGE(PG8_SA(0, 1), a2 + hstep, voffA);
            PG8_WAIT_L(8); PG8_BAR; PG8_WAIT_L(0); PG8_MMA(0, 0, At, B0); PG8_BAR; PG8_SCHED;
            PG8_LDB(B1, 1, 1); PG8_STAGE(PG8_SB(1, 0), b3, voffB);
            PG8_BAR; PG8_WAIT_L(0); PG8_MMA(0, 1, At, B1); PG8_BAR;
            PG8_LDA(At, 1, 1); PG8_STAGE(PG8_SA(1, 0), a3, voffA);
            PG8_BAR; PG8_WAIT_L(0); PG8_MMA(1, 0, At, B0); PG8_BAR; PG8_SCHED;
            PG8_STAGE(PG8_SB(1, 1), b3 + hstep, voffB);
            PG8_WAIT_V(6); PG8_BAR; PG8_MMA(1, 1, At, B1); PG8_BAR;
        }
        E(acc, cur, wr, wc, fr, fq);
        if (!has_next) break;
#pragma unroll
        for (int a = 0; a < 2; ++a)
#pragma unroll
            for (int b = 0; b < 2; ++b)
#pragma unroll
                for (int m = 0; m < 4; ++m)
#pragma unroll
                    for (int n = 0; n < 2; ++n) acc[a][b][m][n] = (f32x4){0.f, 0.f, 0.f, 0.f};
        cur = nxt; cA = nA; cB = nB; ++ui;
    }
    PG8_WAIT_V(0);
    if (wr == 0) PG8_BAR;
    PG8_BAR;
#undef PG8_SA
#undef PG8_SB
#undef PG8_STAGE
#undef PG8_LDA
#undef PG8_LDB
#undef PG8_MMA
#undef PG8_WAIT_V
#undef PG8_WAIT_L
#undef PG8_BAR
#undef PG8_SCHED
}
}
using pg8::Unit;
typedef f32x4 AccT[2][2][4][2];


struct EpiSwiGLU {
    static constexpr bool PERM = true;
    bf16_t* H;
    __device__ __forceinline__ void operator()(const AccT& acc, const Unit& u, int wr, int wc, int fr, int fq) const {
        asm volatile("" : "+v"(fr), "+v"(fq));
        const int row0 = u.pm * 256 + wr * 64 + fr, hc0 = u.pn * 128 + wc * 32 + 8 * fq;
#pragma unroll
        for (int ai = 0; ai < 2; ++ai)
#pragma unroll
            for (int m = 0; m < 4; ++m) {
                const f32x4 a0 = acc[ai][0][m][0], a1 = acc[ai][0][m][1], b0 = acc[ai][1][m][0], b1 = acc[ai][1][m][1];
                u32x4 w;
                w.x = cvt_pk_bf16(silu_f(a0[0]) * b0[0], silu_f(a0[1]) * b0[1]); w.y = cvt_pk_bf16(silu_f(a0[2]) * b0[2], silu_f(a0[3]) * b0[3]);
                w.z = cvt_pk_bf16(silu_f(a1[0]) * b1[0], silu_f(a1[1]) * b1[1]); w.w = cvt_pk_bf16(silu_f(a1[2]) * b1[2], silu_f(a1[3]) * b1[3]);
                *(u32x4*)(H + (size_t)(row0 + ai * 128 + m * 16) * DFF + hc0) = w;
            }
    }
};

struct EpiResid {
    static constexpr bool PERM = false;
    const float* res_x; const float* res_c; float* out_x; float* out_c; const float* gate; float gs;
    __device__ __forceinline__ void operator()(const AccT& acc, const Unit& u, int wr, int wc, int fr, int fq) const {
        asm volatile("" : "+v"(fr), "+v"(fq));
        const int rowt = u.pm * 256; const bool isc = rowt >= MX;
        const int b = isc ? 32 : (rowt >> 11);
        const float* res = isc ? res_c + (size_t)(rowt - MX) * DM : res_x + (size_t)rowt * DM;
        float* out = isc ? out_c + (size_t)(rowt - MX) * DM : out_x + (size_t)rowt * DM;
        const int col0 = u.pn * 256 + wc * 32 + 4 * fq;
        f32x4 gv[2][2];
#pragma unroll
        for (int bj = 0; bj < 2; ++bj)
#pragma unroll
            for (int n = 0; n < 2; ++n) gv[bj][n] = *(const f32x4*)(gate + (size_t)b * NMOD + col0 + bj * 128 + n * 16) * gs;
#pragma unroll
        for (int ai = 0; ai < 2; ++ai) {
            const size_t ro = (size_t)(wr * 64 + fr + ai * 128) * DM + col0;
            f32x4 r[4][2][2];
#pragma unroll
            for (int m = 0; m < 4; ++m)
#pragma unroll
                for (int bj = 0; bj < 2; ++bj)
#pragma unroll
                    for (int n = 0; n < 2; ++n) r[m][bj][n] = *(const f32x4*)(res + ro + (size_t)m * 16 * DM + bj * 128 + n * 16);
#pragma unroll
            for (int m = 0; m < 4; ++m)
#pragma unroll
                for (int bj = 0; bj < 2; ++bj)
#pragma unroll
                    for (int n = 0; n < 2; ++n) *(f32x4*)(out + ro + (size_t)m * 16 * DM + bj * 128 + n * 16) = r[m][bj][n] + gv[bj][n] * acc[ai][bj][m][n];
        }
    }
};

struct EpiResidBf {
    static constexpr bool PERM = true;
    const float* res_x; bf16_t* hb; const float* gate; float gs;
    __device__ __forceinline__ void operator()(const AccT& acc, const Unit& u, int wr, int wc, int fr, int fq) const {
        asm volatile("" : "+v"(fr), "+v"(fq));
        const int rowt = u.pm * 256; const int b = rowt >> 11;
        const float* res = res_x + (size_t)rowt * DM; bf16_t* out = hb + (size_t)rowt * DM;
        const int col0 = u.pn * 256 + wc * 32 + 8 * fq;
        f32x4 gv[2][2];
#pragma unroll
        for (int bj = 0; bj < 2; ++bj)
#pragma unroll
            for (int n = 0; n < 2; ++n) gv[bj][n] = *(const f32x4*)(gate + (size_t)b * NMOD + col0 + bj * 128 + n * 4) * gs;
#pragma unroll
        for (int ai = 0; ai < 2; ++ai) {
            const size_t ro = (size_t)(wr * 64 + fr + ai * 128) * DM + col0;
            f32x4 r[4][2][2];
#pragma unroll
            for (int m = 0; m < 4; ++m)
#pragma unroll
                for (int bj = 0; bj < 2; ++bj)
#pragma unroll
                    for (int n = 0; n < 2; ++n) r[m][bj][n] = *(const f32x4*)(res + ro + (size_t)m * 16 * DM + bj * 128 + n * 4);
#pragma unroll
            for (int m = 0; m < 4; ++m)
#pragma unroll
                for (int bj = 0; bj < 2; ++bj) {
                    const f32x4 h0 = r[m][bj][0] + gv[bj][0] * acc[ai][bj][m][0], h1 = r[m][bj][1] + gv[bj][1] * acc[ai][bj][m][1];
                    u32x4 w; w.x = cvt_pk_bf16(h0[0], h0[1]); w.y = cvt_pk_bf16(h0[2], h0[3]); w.z = cvt_pk_bf16(h1[0], h1[1]); w.w = cvt_pk_bf16(h1[2], h1[3]);
                    *(u32x4*)(out + ro + (size_t)m * 16 * DM + bj * 128) = w;
                }
        }
    }
};

struct EpiResidBfBf {
    static constexpr bool PERM = true;
    const bf16_t* res_b; bf16_t* hb; const float* gate; float gs;
    __device__ __forceinline__ void operator()(const AccT& acc, const Unit& u, int wr, int wc, int fr, int fq) const {
        asm volatile("" : "+v"(fr), "+v"(fq));
        const int rowt = u.pm * 256; const int b = rowt >> 11;
        const bf16_t* res = res_b + (size_t)rowt * DM; bf16_t* out = hb + (size_t)rowt * DM;
        const int col0 = u.pn * 256 + wc * 32 + 8 * fq;
        f32x4 gv[2][2];
#pragma unroll
        for (int bj = 0; bj < 2; ++bj)
#pragma unroll
            for (int n = 0; n < 2; ++n) gv[bj][n] = *(const f32x4*)(gate + (size_t)b * NMOD + col0 + bj * 128 + n * 4) * gs;
        u32x4 r[2][4][2];
#pragma unroll
        for (int ai = 0; ai < 2; ++ai)
#pragma unroll
            for (int m = 0; m < 4; ++m)
#pragma unroll
                for (int bj = 0; bj < 2; ++bj) r[ai][m][bj] = *(const u32x4*)(res + (size_t)(wr * 64 + fr + ai * 128 + m * 16) * DM + col0 + bj * 128);
#pragma unroll
        for (int ai = 0; ai < 2; ++ai)
#pragma unroll
            for (int m = 0; m < 4; ++m)
#pragma unroll
                for (int bj = 0; bj < 2; ++bj) {
                    const u32x4 q = r[ai][m][bj];
                    const f32x4 r0 = {bf_lo(q.x), bf_hi(q.x), bf_lo(q.y), bf_hi(q.y)}, r1 = {bf_lo(q.z), bf_hi(q.z), bf_lo(q.w), bf_hi(q.w)};
                    const f32x4 h0 = r0 + gv[bj][0] * acc[ai][bj][m][0], h1 = r1 + gv[bj][1] * acc[ai][bj][m][1];
                    u32x4 w; w.x = cvt_pk_bf16(h0[0], h0[1]); w.y = cvt_pk_bf16(h0[2], h0[3]); w.z = cvt_pk_bf16(h1[0], h1[1]); w.w = cvt_pk_bf16(h1[2], h1[3]);
                    *(u32x4*)(out + (size_t)(wr * 64 + fr + ai * 128 + m * 16) * DM + col0 + bj * 128) = w;
                }
    }
};

struct EpiResidBfC {
    static constexpr bool PERM = true;
    const float* res_x; const float* res_c; bf16_t* hb; const float* gate; float gs;
    __device__ __forceinline__ void operator()(const AccT& acc, const Unit& u, int wr, int wc, int fr, int fq) const {
        asm volatile("" : "+v"(fr), "+v"(fq));
        const int rowt = u.pm * 256; const bool isc = rowt >= MX; const int b = isc ? 32 : (rowt >> 11);
        const float* res = isc ? res_c + (size_t)(rowt - MX) * DM : res_x + (size_t)rowt * DM; bf16_t* out = hb + (size_t)rowt * DM;
        const int col0 = u.pn * 256 + wc * 32 + 8 * fq;
        f32x4 gv[2][2];
#pragma unroll
        for (int bj = 0; bj < 2; ++bj)
#pragma unroll
            for (int n = 0; n < 2; ++n) gv[bj][n] = *(const f32x4*)(gate + (size_t)b * NMOD + col0 + bj * 128 + n * 4) * gs;
#pragma unroll
        for (int ai = 0; ai < 2; ++ai) {
            const size_t ro = (size_t)(wr * 64 + fr + ai * 128) * DM + col0;
            f32x4 r[4][2][2];
#pragma unroll
            for (int m = 0; m < 4; ++m)
#pragma unroll
                for (int bj = 0; bj < 2; ++bj)
#pragma unroll
                    for (int n = 0; n < 2; ++n) r[m][bj][n] = *(const f32x4*)(res + ro + (size_t)m * 16 * DM + bj * 128 + n * 4);
#pragma unroll
            for (int m = 0; m < 4; ++m)
#pragma unroll
                for (int bj = 0; bj < 2; ++bj) {
                    const f32x4 h0 = r[m][bj][0] + gv[bj][0] * acc[ai][bj][m][0], h1 = r[m][bj][1] + gv[bj][1] * acc[ai][bj][m][1];
                    u32x4 w; w.x = cvt_pk_bf16(h0[0], h0[1]); w.y = cvt_pk_bf16(h0[2], h0[3]); w.z = cvt_pk_bf16(h1[0], h1[1]); w.w = cvt_pk_bf16(h1[2], h1[3]);
                    *(u32x4*)(out + ro + (size_t)m * 16 * DM + bj * 128) = w;
                }
        }
    }
};

struct EpiInProj {
    static constexpr bool PERM = true;
    bf16_t* P; const float* ropeA;
    bf16_t* KTZ; const float* lgd;
    __device__ __forceinline__ void operator()(const AccT& acc, const Unit& u, int wr, int wc, int fr, int fq) const {
        asm volatile("" : "+v"(fr), "+v"(fq));
        const int row0 = u.pm * 256 + wr * 64 + fr, col0 = u.pn * 256 + wc * 32 + 8 * fq;
        const bool rope = u.pn < 2, ktile = u.pn == 1;
        const int i = 4 * (wc & 1) + fq;
#pragma unroll
        for (int ai = 0; ai < 2; ++ai)
#pragma unroll
            for (int m = 0; m < 4; ++m) {
                const int row = row0 + ai * 128 + m * 16;
                f32x4 cs = {1.f, 1.f, 1.f, 1.f}, sn = {0.f, 0.f, 0.f, 0.f};
                if (rope) { const int t = row & 2047; const int pos = (i < 4) ? (t >> 6) : (t & 63);
                    cs = *(const f32x4*)(ropeA + pos * 16 + ((4 * i) & 15)); sn = *(const f32x4*)(ropeA + 1024 + pos * 16 + ((4 * i) & 15)); }
#pragma unroll
                for (int bj = 0; bj < 2; ++bj) {
                    const f32x4 t1 = acc[ai][bj][m][0], t2 = acc[ai][bj][m][1];
                    f32x4 o1 = t1 * cs - t2 * sn, o2 = t2 * cs + t1 * sn;
                    if (!rope) {
#pragma unroll
                        for (int jj = 0; jj < 4; ++jj) { o1[jj] = silu_f(t1[jj]); o2[jj] = silu_f(t2[jj]); }
                    }
                    u32x4 w; w.x = cvt_pk_bf16(o1[0], o1[1]); w.y = cvt_pk_bf16(o1[2], o1[3]); w.z = cvt_pk_bf16(o2[0], o2[1]); w.w = cvt_pk_bf16(o2[2], o2[3]);
                    *(u32x4*)(P + (size_t)row * PW + col0 + bj * 128) = w;
                    if (ktile) {
                        const int hh = 2 * bj + (wc >> 1), o = wr * 64 + fr + m * 16;
                        const float zf = exp2f((float)(127 - o) * (lgd[hh] * 1.4426950408889634f)), zb = exp2f((float)o * (lgd[4 + hh] * 1.4426950408889634f));
                        bf16_t* kf = KTZ + (size_t)(wc * 32 + 8 * fq + bj * 128) * MX + row; bf16_t* kb = kf + (size_t)256 * MX;
#pragma unroll
                        for (int e = 0; e < 8; ++e) { const float v = e < 4 ? o1[e & 3] : o2[e & 3]; const unsigned pk = cvt_pk_bf16(v * zf, v * zb);
                            kf[(size_t)e * MX] = (bf16_t)(pk & 0xffffu); kb[(size_t)e * MX] = (bf16_t)(pk >> 16); }
                    }
                }
            }
    }
};

template <bool ROPE> struct EpiSwapK {
    static constexpr bool PERM = true;
    bf16_t* KTZ; const float* ropeA; const float* lgd; int NT;
    __device__ __forceinline__ void operator()(const AccT& acc, const Unit& u, int wr, int wc, int fr, int fq) const {
        asm volatile("" : "+v"(fr), "+v"(fq));
        const int rbase = wr * 64 + fr;
        const int tb = u.pn * 256 + wc * 32 + 8 * fq;
        const int o0 = wc * 32 + 8 * fq;
        const int j = fr & 3; const float sgn = ((fr >> 2) & 1) ? 1.0f : -1.0f;
#pragma unroll
        for (int ai = 0; ai < 2; ++ai) {
            const int hh = 2 * ai + wr;
            const float l2f = lgd[hh] * 1.4426950408889634f, l2b = lgd[4 + hh] * 1.4426950408889634f;
            const float zf0 = exp2f((float)(127 - o0) * l2f), zfs = exp2f(-l2f), zb0 = exp2f((float)o0 * l2b), zbs = exp2f(l2b);
#pragma unroll
            for (int m = 0; m < 4; ++m) {
                const int r = rbase + ai * 128 + m * 16;
                const int d = 4 * (2 * m + (fr >> 3)) + j;
#pragma unroll
                for (int bj = 0; bj < 2; ++bj) {
                    const int t0 = tb + bj * 128;
                    float v[8];
#pragma unroll
                    for (int jj = 0; jj < 4; ++jj) { v[jj] = acc[ai][bj][m][0][jj]; v[4 + jj] = acc[ai][bj][m][1][jj]; }
                    if constexpr (ROPE) {
                        const int t = t0 & 2047;
#pragma unroll
                        for (int hf = 0; hf < 2; ++hf) {
                            f32x4 cs, sn;
                            if (m < 2) { const float c1 = ropeA[(t >> 6) * 16 + d], s1 = ropeA[1024 + (t >> 6) * 16 + d]; cs = (f32x4){c1, c1, c1, c1}; sn = (f32x4){s1, s1, s1, s1}; }
                            else { const float* cb = ropeA + 2048 + (d - 16) * 64 + (t & 63) + 4 * hf; cs = *(const f32x4*)(cb); sn = *(const f32x4*)(cb + 1024); }
#pragma unroll
                            for (int jj = 0; jj < 4; ++jj) { const float pr = __shfl_xor(v[4 * hf + jj], 4); v[4 * hf + jj] = v[4 * hf + jj] * cs[jj] + sgn * pr * sn[jj]; }
                            __builtin_amdgcn_sched_barrier(0);
                        }
                    }
                    float zf[8], zb[8]; zf[0] = zf0; zb[0] = zb0;
#pragma unroll
                    for (int jj = 1; jj < 8; ++jj) { zf[jj] = zf[jj - 1] * zfs; zb[jj] = zb[jj - 1] * zbs; }
                    u32x4 wf, wb;
                    wf.x = cvt_pk_bf16(v[0] * zf[0], v[1] * zf[1]); wf.y = cvt_pk_bf16(v[2] * zf[2], v[3] * zf[3]); wf.z = cvt_pk_bf16(v[4] * zf[4], v[5] * zf[5]); wf.w = cvt_pk_bf16(v[6] * zf[6], v[7] * zf[7]);
                    wb.x = cvt_pk_bf16(v[0] * zb[0], v[1] * zb[1]); wb.y = cvt_pk_bf16(v[2] * zb[2], v[3] * zb[3]); wb.z = cvt_pk_bf16(v[4] * zb[4], v[5] * zb[5]); wb.w = cvt_pk_bf16(v[6] * zb[6], v[7] * zb[7]);
                    *(u32x4*)(KTZ + (size_t)r * NT + t0) = wf;
                    *(u32x4*)(KTZ + (size_t)(256 + r) * NT + t0) = wb;
                    __builtin_amdgcn_sched_barrier(0);
                }
            }
        }
    }
};
struct EpiSwapVF {
    static constexpr bool PERM = true;
    bf16_t* VT; int NT;
    __device__ __forceinline__ void operator()(const AccT& acc, const Unit& u, int wr, int wc, int fr, int fq) const {
        asm volatile("" : "+v"(fr), "+v"(fq));
        const int rbase = u.pm * 256 + wr * 64 + fr;
        const int tb = u.pn * 256 + wc * 32 + 8 * fq;
#pragma unroll
        for (int ai = 0; ai < 2; ++ai)
#pragma unroll
            for (int m = 0; m < 4; ++m) {
                const int r = rbase + ai * 128 + m * 16;
#pragma unroll
                for (int bj = 0; bj < 2; ++bj) {
                    const int t0 = tb + bj * 128;
                    const f32x4 v0 = acc[ai][bj][m][0], v1 = acc[ai][bj][m][1];
                    u32x4 w; w.x = cvt_pk_bf16(v0[0], v0[1]); w.y = cvt_pk_bf16(v0[2], v0[3]); w.z = cvt_pk_bf16(v1[0], v1[1]); w.w = cvt_pk_bf16(v1[2], v1[3]);
                    *(u32x4*)(VT + (size_t)r * NT + t0) = w;
                }
            }
    }
};
struct EpiSwapF {
    static constexpr bool PERM = true;
    bf16_t* YT; int part;
    __device__ __forceinline__ void operator()(const AccT& acc, const Unit& u, int wr, int wc, int fr, int fq) const {
        asm volatile("" : "+v"(fr), "+v"(fq));
        const int rbase = u.pm * 256 + wr * 64 + fr;
        const int tb = u.pn * 256 + wc * 32 + 8 * fq;
#pragma unroll
        for (int ai = 0; ai < 2; ++ai)
#pragma unroll
            for (int m = 0; m < 4; ++m) {
                const int gm = rbase + ai * 128 + m * 16;
#pragma unroll
                for (int bj = 0; bj < 2; ++bj) {
                    const int t0 = tb + bj * 128;
                    const f32x4 v0 = acc[ai][bj][m][0], v1 = acc[ai][bj][m][1];
                    u32x4 w; w.x = cvt_pk_bf16(v0[0], v0[1]); w.y = cvt_pk_bf16(v0[2], v0[3]); w.z = cvt_pk_bf16(v1[0], v1[1]); w.w = cvt_pk_bf16(v1[2], v1[3]);
                    *(u32x4*)(YT + ((size_t)((t0 >> 10) * 512 + gm)) * 2048 + part * 1024 + (t0 & 1023)) = w;
                }
            }
    }
};

struct EpiFour {
    static constexpr bool PERM = true;
    bf16_t* CAT; const float* YCH;
    __device__ __forceinline__ void operator()(const AccT& acc, const Unit& u, int wr, int wc, int fr, int fq) const {
        asm volatile("" : "+v"(fr), "+v"(fq));
        const int row0 = u.pm * 256 + wr * 64 + fr; const int b = u.pn >> 1, ch0 = (u.pn & 1) * 256 + wc * 32 + 8 * fq;
        const float sg = (fr & 1) ? -1.0f : 1.0f;
        f32x4 yh[2][2];
#pragma unroll
        for (int bj = 0; bj < 2; ++bj)
#pragma unroll
            for (int n = 0; n < 2; ++n) yh[bj][n] = *(const f32x4*)(YCH + b * 512 + ch0 + bj * 128 + 4 * n) * sg;
#pragma unroll
        for (int ai = 0; ai < 2; ++ai)
#pragma unroll
            for (int m = 0; m < 4; ++m) {
                const int k = row0 + ai * 128 + m * 16;
#pragma unroll
                for (int bj = 0; bj < 2; ++bj) {
                    const f32x4 v0 = acc[ai][bj][m][0] + yh[bj][0], v1 = acc[ai][bj][m][1] + yh[bj][1];
                    u32x4 w; w.x = cvt_pk_bf16(v0[0], v0[1]); w.y = cvt_pk_bf16(v0[2], v0[3]); w.z = cvt_pk_bf16(v1[0], v1[1]); w.w = cvt_pk_bf16(v1[2], v1[3]);
                    *(u32x4*)(CAT + (size_t)(b * 2048 + k) * CATW + 1024 + ch0 + bj * 128) = w;
                }
            }
    }
};

template <class Epi>
__device__ __forceinline__ void run_gemm(LAS unsigned char* lds, const bf16_t* A, const bf16_t* Bt, int M, int N, int K, const Epi& E, int rot = 0, int rev = 0) {
    pg8::Gemm g; g.A = A; g.Bt = Bt; g.M = M; g.N = N; g.K = K;
    pg8::StaticOrder S; S.init(M, N, (int)gridDim.x, (int)((blockIdx.x + rot) % gridDim.x), rev);
    pg8::gemm_phase<Epi, pg8::StaticOrder>(lds, g, S, E);
}

__device__ __forceinline__ void prep_tile(unsigned char* shm, const float* src, int sld, int srow0, int scol0, bf16_t* dst, int dld, int r0, int k0, bool perm, float scale) {
    float* tile = (float*)shm;
    const int t = threadIdx.x, tx = t & 127, ty = t >> 7;
    __syncthreads();
    float ld[16];
#pragma unroll
    for (int q = 0; q < 16; ++q) ld[q] = src[(size_t)(srow0 + ty + 4 * q) * sld + scol0 + tx];
#pragma unroll
    for (int q = 0; q < 16; ++q) tile[(ty + 4 * q) * 129 + tx] = ld[q];
    __syncthreads();
    const int rr = t >> 2, ks = (t & 3) * 16;
    const int r6 = rr & 63;
    const int sc = perm ? ((rr & 64) + 32 * ((r6 >> 2) & 1) + 4 * (r6 >> 3) + (r6 & 3)) : rr;
#pragma unroll
    for (int hq = 0; hq < 2; ++hq) {
        float v[8];
#pragma unroll
        for (int q = 0; q < 8; ++q) v[q] = tile[(ks + hq * 8 + q) * 129 + sc] * scale;
        u32x4 w; w.x = cvt_pk_bf16(v[0], v[1]); w.y = cvt_pk_bf16(v[2], v[3]); w.z = cvt_pk_bf16(v[4], v[5]); w.w = cvt_pk_bf16(v[6], v[7]);
        *(u32x4*)(dst + (size_t)(r0 + rr) * dld + k0 + ks + hq * 8) = w;
    }
}

__device__ __forceinline__ void phase_prep(unsigned char* shm, const Params& p, int set, int first, int stride) {
    constexpr int J0 = 704, J1 = J0 + 352, J2 = J1 + 704, J3 = J2 + 352, J4 = J3 + 192, J5 = J4 + 96, J6 = J5 + 192, J7 = J6 + 256, J8 = J7 + 256, J9 = J8 + 144, J10 = J9 + 1;
    unsigned char* ws = p.ws;
    const int tid = threadIdx.x;
    constexpr int V0 = J1 + (J10 - J8), V1 = J8 - J1;
    for (int v = first; v < (set ? V1 : V0); v += stride) {
        constexpr int M0 = J10 - J8;
        const int job = set ? v + J1 : (v < M0 ? v + J8 : v - M0);
        if (job < J0 || (job >= J1 && job < J2)) {
            const bool second = job >= J1; const int jj = second ? job - J1 : job; const int rg = jj >> 4, kb = jj & 15;
            const int pn = rg >> 1, bj = rg & 1;
            prep_tile(shm, second ? p.w13_2 : p.w13_1, 5632, 64 * kb, bj * DFF + 128 * pn, (bf16_t*)(ws + (second ? OFF_WB13_2 : OFF_WB13_1)), 1024, 128 * rg, 64 * kb, false, 1.f);
        } else if (job < J1 || (job >= J2 && job < J3)) {
            const bool second = job >= J2; const int jj = second ? job - J2 : job - J0; const int rg = jj / 44, kb = jj % 44;
            prep_tile(shm, second ? p.w2_2 : p.w2_1, 1024, 64 * kb, 128 * rg, (bf16_t*)(ws + (second ? OFF_WB2_2 : OFF_WB2_1)), DFF, 128 * rg, 64 * kb, false, 1.f);
        } else if (job < J4) {
            const int jj = job - J3, rg = jj >> 4, kb = jj & 15;
            const int sc0 = rg < 4 ? 128 * rg : 128 * rg + 512;
            prep_tile(shm, p.w_in, 2560, 64 * kb, sc0, (bf16_t*)(ws + OFF_WBIN), 1024, 128 * rg, 64 * kb, rg < 4, (rg >= 2 && rg < 4) ? 0.125f : 1.f);
        } else if (job < J5) {
            const int jj = job - J4, rg = jj >> 4, kb = jj & 15;
            const int sc0 = rg < 2 ? 256 + 128 * rg : 512 + 128 * (rg - 2);
            prep_tile(shm, p.w_in, 2560, 64 * kb, sc0, (bf16_t*)(ws + OFF_WSW), 1024, 128 * rg, 64 * kb, rg < 2, rg < 2 ? 0.125f : 1.f);
        } else if (job < J6) {
            const int jj = job - J5, rg = jj / 24, kb = jj % 24;
            prep_tile(shm, p.w_out, 1024, kb < 8 ? 64 * kb : 64 * (kb - 8), 128 * rg, (bf16_t*)(ws + OFF_WOUT3), 1536, 128 * rg, 64 * kb, false, 1.f);
        } else if (job < J7) {
            const int jj = job - J6, g = jj >> 6, k0 = (jj & 63) * 16;
            float* wl = (float*)shm;
            float* trig = wl + 16 * 128;
            __syncthreads();
            for (int q = tid; q < 16 * 128; q += 512) wl[q] = p.w_in[(size_t)(k0 + (q >> 7)) * 2560 + 2048 + g * 128 + (q & 127)];
            if (tid < 128) trig[tid] = cospif((float)tid * (1.0f / 64.0f));
            __syncthreads();
            const int pm = tid & 255, kh = tid >> 8, part = pm >> 7, m = pm & 127;
            float a[8];
#pragma unroll
            for (int q = 0; q < 8; ++q) a[q] = 0.f;
            for (int c = 0; c < 128; ++c) {
                const int idx = (m * c) & 127;
                const float tr = part ? -trig[(idx + 96) & 127] : trig[idx];
#pragma unroll
                for (int q = 0; q < 8; ++q) a[q] += wl[(kh * 8 + q) * 128 + c] * tr;
            }
            u32x4 w; const float sc = 1.0f / 512.0f;
            w.x = cvt_pk_bf16(a[0] * sc, a[1] * sc); w.y = cvt_pk_bf16(a[2] * sc, a[3] * sc); w.z = cvt_pk_bf16(a[4] * sc, a[5] * sc); w.w = cvt_pk_bf16(a[6] * sc, a[7] * sc);
            *(u32x4*)((bf16_t*)(ws + OFF_WSW) + (size_t)(768 + part * 512 + g * 128 + m) * 1024 + k0 + kh * 8) = w;
        } else if (job < J8) {
            const int jj = job - J7; float* ct = (float*)shm;
            __syncthreads();
            for (int q = tid; q < 2048; q += 512) ct[q] = cospif((float)q * (1.0f / 1024.0f));
            __syncthreads();
            bf16_t* TT = (bf16_t*)(ws + OFF_TT);
            for (int q = tid; q < 8 * 256; q += 512) {
                const int k = jj * 8 + (q >> 8), pc = q & 255, part = pc >> 7, n0 = (pc & 127) * 8;
                float v[8];
#pragma unroll
                for (int e = 0; e < 8; ++e) { const int idx = (k * (n0 + e)) & 2047; v[e] = part ? ct[(idx + 1536) & 2047] : ct[idx]; }
                u32x4 w; w.x = cvt_pk_bf16(v[0], v[1]); w.y = cvt_pk_bf16(v[2], v[3]); w.z = cvt_pk_bf16(v[4], v[5]); w.w = cvt_pk_bf16(v[6], v[7]);
                *(u32x4*)(TT + (size_t)k * 2048 + part * 1024 + n0) = w;
            }
        } else if (job < J9) {
            const int jj = job - J8, col0 = jj * 64; const int wid = tid >> 6, lane = tid & 63;
            float acc[33];
#pragma unroll
            for (int b = 0; b < 33; ++b) acc[b] = 0.f;
            for (int kc = 0; kc < 2; ++kc) {
                const int kb = wid * 128 + kc * 64;
                float cv[33];
#pragma unroll
                for (int b = 0; b < 33; ++b) { const float cc = (b < 32) ? p.c[b * DM + kb + lane] : p.c_ctx[kb + lane]; cv[b] = cc / (1.0f + expf(-cc)); }
#pragma unroll 8
                for (int kk = 0; kk < 64; ++kk) {
                    const float wv = p.w_mod[(size_t)(kb + kk) * NMOD + col0 + lane];
#pragma unroll
                    for (int b = 0; b < 33; ++b) acc[b] += __uint_as_float(__builtin_amdgcn_readlane(__float_as_uint(cv[b]), kk)) * wv;
                }
            }
            float* red = (float*)shm;
            __syncthreads();
#pragma unroll
            for (int b = 0; b < 33; ++b) red[(wid * 33 + b) * 64 + lane] = acc[b];
            __syncthreads();
            float* mod = (float*)(ws + OFF_MOD);
            for (int q = tid; q < 33 * 64; q += 512) {
                const int b = q >> 6, cl = q & 63; float s = p.b_mod[col0 + cl];
#pragma unroll
                for (int w = 0; w < 8; ++w) s += red[(w * 33 + b) * 64 + cl];
                mod[(size_t)b * NMOD + col0 + cl] = s;
            }
        } else {
            float* R = (float*)(ws + OFF_ROPE);
            for (int q = tid; q < 1024; q += 512) {
                const int pos = q >> 4, f = q & 15;
                const float inv = powf(10000.0f, -(float)f / 16.0f); const float ang = (float)pos * inv;
                const float cs = cosf(ang), sn = sinf(ang);
                R[pos * 16 + f] = cs; R[1024 + pos * 16 + f] = sn; R[2048 + f * 64 + pos] = cs; R[3072 + f * 64 + pos] = sn;
            }
        }
    }
}

template <int R>
__device__ __forceinline__ void phase_norm_mod(const float* src_x, const float* src_c, int nrows, const float* g, const float* mod, int shift_off, int scale_off, bf16_t* dst, int row_begin = 0, bool local = false) {
    int tid_ = threadIdx.x; asm volatile("" : "+v"(tid_));
    const int wid = tid_ >> 6, lane = tid_ & 63;
    const int first = row_begin + (local ? wid : blockIdx.x * 8 * R + wid), step = local ? 8 * R : gridDim.x * 8 * R;
    for (int row0 = first; row0 < nrows; row0 += step) {
        const int b = row0 < MX ? (row0 >> 11) : 32;
        f32x4 v[R][4], gg[4], sc[4], sh[4];
#pragma unroll
        for (int j = 0; j < R; ++j) { const int row = row0 + 8 * j; const float* s = row < MX ? src_x + (size_t)row * DM : src_c + (size_t)(row - MX) * DM;
#pragma unroll
            for (int i = 0; i < 4; ++i) v[j][i] = (row < nrows) ? *(const f32x4*)(s + i * 256 + lane * 4) : (f32x4){0.f, 0.f, 0.f, 0.f}; }
#pragma unroll
        for (int i = 0; i < 4; ++i) { const int col = i * 256 + lane * 4; gg[i] = *(const f32x4*)(g + col); sc[i] = *(const f32x4*)(mod + (size_t)b * NMOD + scale_off + col) + 1.0f; sh[i] = *(const f32x4*)(mod + (size_t)b * NMOD + shift_off + col); }
#pragma unroll
        for (int j = 0; j < R; ++j) {
            const int row = row0 + 8 * j;
            float ss = 0.f;
#pragma unroll
            for (int i = 0; i < 4; ++i) ss += v[j][i][0] * v[j][i][0] + v[j][i][1] * v[j][i][1] + v[j][i][2] * v[j][i][2] + v[j][i][3] * v[j][i][3];
#pragma unroll
            for (int o = 32; o >= 1; o >>= 1) ss += __shfl_xor(ss, o);
            const float r = rsqrtf(ss * (1.0f / 1024.0f) + 1e-6f);
            if (row < nrows) {
#pragma unroll
                for (int i = 0; i < 4; ++i) { const f32x4 y = (v[j][i] * r) * gg[i] * sc[i] + sh[i]; u32x2 w; w.x = cvt_pk_bf16(y[0], y[1]); w.y = cvt_pk_bf16(y[2], y[3]);
                    *(u32x2*)(dst + (size_t)row * DM + i * 256 + lane * 4) = w; }
            }
        }
    }
}
template <int R>
__device__ __forceinline__ void phase_norm_mod_bf(const bf16_t* src, int nrows, const float* g, const float* mod, int shift_off, int scale_off, bf16_t* dst, int row_begin = 0) {
    int tid_ = threadIdx.x; asm volatile("" : "+v"(tid_));
    const int wid = tid_ >> 6, lane = tid_ & 63;
    for (int row0 = row_begin + blockIdx.x * 8 * R + wid; row0 < nrows; row0 += gridDim.x * 8 * R) {
        const int b = row0 < MX ? (row0 >> 11) : 32;
        u32x4 v[R][2]; f32x4 gg[2][2], sc[2][2], sh[2][2];
#pragma unroll
        for (int j = 0; j < R; ++j)
#pragma unroll
            for (int i = 0; i < 2; ++i) v[j][i] = *(const u32x4*)(src + (size_t)(row0 + 8 * j) * DM + i * 512 + lane * 8);
#pragma unroll
        for (int i = 0; i < 2; ++i)
#pragma unroll
            for (int n = 0; n < 2; ++n) { const int col = i * 512 + lane * 8 + 4 * n; gg[i][n] = *(const f32x4*)(g + col); sc[i][n] = *(const f32x4*)(mod + (size_t)b * NMOD + scale_off + col) + 1.0f; sh[i][n] = *(const f32x4*)(mod + (size_t)b * NMOD + shift_off + col); }
#pragma unroll
        for (int j = 0; j < R; ++j) {
            f32x4 x[2][2]; float ss = 0.f;
#pragma unroll
            for (int i = 0; i < 2; ++i) { x[i][0] = (f32x4){bf_lo(v[j][i].x), bf_hi(v[j][i].x), bf_lo(v[j][i].y), bf_hi(v[j][i].y)}; x[i][1] = (f32x4){bf_lo(v[j][i].z), bf_hi(v[j][i].z), bf_lo(v[j][i].w), bf_hi(v[j][i].w)};
                ss += x[i][0][0] * x[i][0][0] + x[i][0][1] * x[i][0][1] + x[i][0][2] * x[i][0][2] + x[i][0][3] * x[i][0][3] + x[i][1][0] * x[i][1][0] + x[i][1][1] * x[i][1][1] + x[i][1][2] * x[i][1][2] + x[i][1][3] * x[i][1][3]; }
#pragma unroll
            for (int o = 32; o >= 1; o >>= 1) ss += __shfl_xor(ss, o);
            const float r = rsqrtf(ss * (1.0f / 1024.0f) + 1e-6f);
#pragma unroll
            for (int i = 0; i < 2; ++i) { const f32x4 y0 = (x[i][0] * r) * gg[i][0] * sc[i][0] + sh[i][0], y1 = (x[i][1] * r) * gg[i][1] * sc[i][1] + sh[i][1];
                u32x4 w; w.x = cvt_pk_bf16(y0[0], y0[1]); w.y = cvt_pk_bf16(y0[2], y0[3]); w.z = cvt_pk_bf16(y1[0], y1[1]); w.w = cvt_pk_bf16(y1[2], y1[3]);
                *(u32x4*)(dst + (size_t)(row0 + 8 * j) * DM + i * 512 + lane * 8) = w; }
        }
    }
}

__device__ __forceinline__ void phase_norm_mix_pairs(const float* src, const float* g, const float* mod, int shift_off, int scale_off, bf16_t* dst, bf16_t* A2e, bf16_t* A2o) {
    int tid_ = threadIdx.x; asm volatile("" : "+v"(tid_));
    const int wid = tid_ >> 6, lane = tid_ & 63;
    for (int it = blockIdx.x * 8 + wid; it < 32 * 1025; it += gridDim.x * 8) {
        const int b = it / 1025, n = it - b * 1025;
        const bool pair = (n >= 1) && (n <= 1023);
        const int r1 = b * 2048 + n, r2 = pair ? b * 2048 + 2048 - n : r1;
        const float* s1 = src + (size_t)r1 * DM; const float* s2 = src + (size_t)r2 * DM;
        f32x4 v1[4], v2[4], gg[4], sc[4], sh[4]; float ss1 = 0.f, ss2 = 0.f;
#pragma unroll
        for (int i = 0; i < 4; ++i) { v1[i] = *(const f32x4*)(s1 + i * 256 + lane * 4); v2[i] = *(const f32x4*)(s2 + i * 256 + lane * 4); }
#pragma unroll
        for (int i = 0; i < 4; ++i) { const int col = i * 256 + lane * 4; gg[i] = *(const f32x4*)(g + col); sc[i] = *(const f32x4*)(mod + (size_t)b * NMOD + scale_off + col); sh[i] = *(const f32x4*)(mod + (size_t)b * NMOD + shift_off + col); }
#pragma unroll
        for (int i = 0; i < 4; ++i) { ss1 += v1[i][0] * v1[i][0] + v1[i][1] * v1[i][1] + v1[i][2] * v1[i][2] + v1[i][3] * v1[i][3]; ss2 += v2[i][0] * v2[i][0] + v2[i][1] * v2[i][1] + v2[i][2] * v2[i][2] + v2[i][3] * v2[i][3]; }
#pragma unroll
        for (int o = 32; o >= 1; o >>= 1) { ss1 += __shfl_xor(ss1, o); ss2 += __shfl_xor(ss2, o); }
        const float ra = rsqrtf(ss1 * (1.0f / 1024.0f) + 1e-6f), rb = rsqrtf(ss2 * (1.0f / 1024.0f) + 1e-6f);
        u32x2 w1[4], w2[4], we[4], wo[4];
#pragma unroll
        for (int i = 0; i < 4; ++i) {
            const f32x4 y1 = (v1[i] * ra) * gg[i] * (sc[i] + 1.0f) + sh[i], y2 = (v2[i] * rb) * gg[i] * (sc[i] + 1.0f) + sh[i];
            const f32x4 ye = pair ? (y1 + y2) : y1, yo = pair ? (y1 - y2) : (f32x4){0.f, 0.f, 0.f, 0.f};
            w1[i].x = cvt_pk_bf16(y1[0], y1[1]); w1[i].y = cvt_pk_bf16(y1[2], y1[3]); w2[i].x = cvt_pk_bf16(y2[0], y2[1]); w2[i].y = cvt_pk_bf16(y2[2], y2[3]);
            we[i].x = cvt_pk_bf16(ye[0], ye[1]); we[i].y = cvt_pk_bf16(ye[2], ye[3]); wo[i].x = cvt_pk_bf16(yo[0], yo[1]); wo[i].y = cvt_pk_bf16(yo[2], yo[3]);
        }
#pragma unroll
        for (int i = 0; i < 4; ++i) {
            const int col = i * 256 + lane * 4;
            *(u32x2*)(dst + (size_t)r1 * DM + col) = w1[i];
            if (pair) *(u32x2*)(dst + (size_t)r2 * DM + col) = w2[i];
            if (n < 1024) { *(u32x2*)(A2e + ((size_t)b * 1024 + n) * DM + col) = we[i]; *(u32x2*)(A2o + ((size_t)b * 1024 + n) * DM + col) = wo[i]; }
        }
    }
}
__device__ __forceinline__ void phase_norm_mix_pairs_bf(const bf16_t* src, const float* g, const float* mod, int shift_off, int scale_off, bf16_t* dst, bf16_t* A2e, bf16_t* A2o) {
    int tid_ = threadIdx.x; asm volatile("" : "+v"(tid_));
    const int wid = tid_ >> 6, lane = tid_ & 63;
    constexpr int PP = 6, NG = (1025 + PP - 1) / PP;
    for (int gi = blockIdx.x * 8 + wid; gi < 32 * NG; gi += gridDim.x * 8) {
        const int b = gi / NG, n0 = (gi - b * NG) * PP;
        u32x4 v1[PP][2], v2[PP][2]; f32x4 gg[2][2], sc[2][2], sh[2][2];
#pragma unroll
        for (int q = 0; q < PP; ++q) {
            const int n = n0 + q < 1025 ? n0 + q : 1024;
            const bool pair = (n >= 1) && (n <= 1023);
            const int r1 = b * 2048 + n, r2 = pair ? b * 2048 + 2048 - n : r1;
#pragma unroll
            for (int i = 0; i < 2; ++i) { v1[q][i] = *(const u32x4*)(src + (size_t)r1 * DM + i * 512 + lane * 8); v2[q][i] = *(const u32x4*)(src + (size_t)r2 * DM + i * 512 + lane * 8); }
        }
#pragma unroll
        for (int i = 0; i < 2; ++i)
#pragma unroll
            for (int n = 0; n < 2; ++n) { const int col = i * 512 + lane * 8 + 4 * n; gg[i][n] = *(const f32x4*)(g + col); sc[i][n] = *(const f32x4*)(mod + (size_t)b * NMOD + scale_off + col) + 1.0f; sh[i][n] = *(const f32x4*)(mod + (size_t)b * NMOD + shift_off + col); }
#pragma unroll
        for (int q = 0; q < PP; ++q) {
            const int n = n0 + q;
            const bool valid = n < 1025, pair = (n >= 1) && (n <= 1023);
            const int r1 = b * 2048 + n, r2 = b * 2048 + 2048 - n;
            f32x4 x1[2][2], x2[2][2]; float ss1 = 0.f, ss2 = 0.f;
#pragma unroll
            for (int i = 0; i < 2; ++i) {
                x1[i][0] = (f32x4){bf_lo(v1[q][i].x), bf_hi(v1[q][i].x), bf_lo(v1[q][i].y), bf_hi(v1[q][i].y)}; x1[i][1] = (f32x4){bf_lo(v1[q][i].z), bf_hi(v1[q][i].z), bf_lo(v1[q][i].w), bf_hi(v1[q][i].w)};
                x2[i][0] = (f32x4){bf_lo(v2[q][i].x), bf_hi(v2[q][i].x), bf_lo(v2[q][i].y), bf_hi(v2[q][i].y)}; x2[i][1] = (f32x4){bf_lo(v2[q][i].z), bf_hi(v2[q][i].z), bf_lo(v2[q][i].w), bf_hi(v2[q][i].w)};
#pragma unroll
                for (int n2 = 0; n2 < 2; ++n2) { ss1 += x1[i][n2][0] * x1[i][n2][0] + x1[i][n2][1] * x1[i][n2][1] + x1[i][n2][2] * x1[i][n2][2] + x1[i][n2][3] * x1[i][n2][3];
                                                  ss2 += x2[i][n2][0] * x2[i][n2][0] + x2[i][n2][1] * x2[i][n2][1] + x2[i][n2][2] * x2[i][n2][2] + x2[i][n2][3] * x2[i][n2][3]; }
            }
#pragma unroll
            for (int o = 32; o >= 1; o >>= 1) { ss1 += __shfl_xor(ss1, o); ss2 += __shfl_xor(ss2, o); }
            const float ra = rsqrtf(ss1 * (1.0f / 1024.0f) + 1e-6f), rb = rsqrtf(ss2 * (1.0f / 1024.0f) + 1e-6f);
            if (valid) {
#pragma unroll
                for (int i = 0; i < 2; ++i) {
                    const int col = i * 512 + lane * 8;
                    f32x4 y1[2], y2[2], ye[2], yo[2];
#pragma unroll
                    for (int n2 = 0; n2 < 2; ++n2) { y1[n2] = (x1[i][n2] * ra) * gg[i][n2] * sc[i][n2] + sh[i][n2]; y2[n2] = (x2[i][n2] * rb) * gg[i][n2] * sc[i][n2] + sh[i][n2];
                        ye[n2] = pair ? (y1[n2] + y2[n2]) : y1[n2]; yo[n2] = pair ? (y1[n2] - y2[n2]) : (f32x4){0.f, 0.f, 0.f, 0.f}; }
                    u32x4 w1, w2, we, wo;
                    w1.x = cvt_pk_bf16(y1[0][0], y1[0][1]); w1.y = cvt_pk_bf16(y1[0][2], y1[0][3]); w1.z = cvt_pk_bf16(y1[1][0], y1[1][1]); w1.w = cvt_pk_bf16(y1[1][2], y1[1][3]);
                    w2.x = cvt_pk_bf16(y2[0][0], y2[0][1]); w2.y = cvt_pk_bf16(y2[0][2], y2[0][3]); w2.z = cvt_pk_bf16(y2[1][0], y2[1][1]); w2.w = cvt_pk_bf16(y2[1][2], y2[1][3]);
                    we.x = cvt_pk_bf16(ye[0][0], ye[0][1]); we.y = cvt_pk_bf16(ye[0][2], ye[0][3]); we.z = cvt_pk_bf16(ye[1][0], ye[1][1]); we.w = cvt_pk_bf16(ye[1][2], ye[1][3]);
                    wo.x = cvt_pk_bf16(yo[0][0], yo[0][1]); wo.y = cvt_pk_bf16(yo[0][2], yo[0][3]); wo.z = cvt_pk_bf16(yo[1][0], yo[1][1]); wo.w = cvt_pk_bf16(yo[1][2], yo[1][3]);
                    *(u32x4*)(dst + (size_t)r1 * DM + col) = w1;
                    if (pair) *(u32x4*)(dst + (size_t)r2 * DM + col) = w2;
                    if (n < 1024) { *(u32x4*)(A2e + ((size_t)b * 1024 + n) * DM + col) = we; *(u32x4*)(A2o + ((size_t)b * 1024 + n) * DM + col) = wo; }
                }
            }
        }
    }
}

__device__ __forceinline__ void phase_ych(const bf16_t* A2, const bf16_t* Wc, float* YCH) {
    int tid_ = threadIdx.x; asm volatile("" : "+v"(tid_));
    const int wid = tid_ >> 6, lane = tid_ & 63;
    for (int o = blockIdx.x * 8 + wid; o < 32 * 512; o += gridDim.x * 8) {
        const int b = o >> 9, gm = o & 511;
        const bf16_t* a = A2 + ((size_t)b * 2048 + 1024) * DM + lane * 16; const bf16_t* w = Wc + (size_t)gm * DM + lane * 16;
        float acc = 0.f;
#pragma unroll
        for (int q = 0; q < 2; ++q) { const u32x4 av = *(const u32x4*)(a + q * 8), wv = *(const u32x4*)(w + q * 8);
            acc += bf_lo(av.x) * bf_lo(wv.x) + bf_hi(av.x) * bf_hi(wv.x) + bf_lo(av.y) * bf_lo(wv.y) + bf_hi(av.y) * bf_hi(wv.y) + bf_lo(av.z) * bf_lo(wv.z) + bf_hi(av.z) * bf_hi(wv.z) + bf_lo(av.w) * bf_lo(wv.w) + bf_hi(av.w) * bf_hi(wv.w); }
#pragma unroll
        for (int sft = 32; sft >= 1; sft >>= 1) acc += __shfl_xor(acc, sft);
        if (lane == 0) YCH[o] = acc;
    }
}
__device__ __forceinline__ void phase_final_norm(const bf16_t* hb, float* out, const float* g) {
    int tid_ = threadIdx.x; asm volatile("" : "+v"(tid_));
    const int wid = tid_ >> 6, lane = tid_ & 63;
    constexpr int R = 8;
    f32x4 gg[2][2];
#pragma unroll
    for (int i = 0; i < 2; ++i) { gg[i][0] = *(const f32x4*)(g + i * 512 + lane * 8); gg[i][1] = *(const f32x4*)(g + i * 512 + lane * 8 + 4); }
    for (int row0 = blockIdx.x * 8 * R + wid; row0 < MX; row0 += gridDim.x * 8 * R) {
        u32x4 v[R][2];
#pragma unroll
        for (int j = 0; j < R; ++j)
#pragma unroll
            for (int i = 0; i < 2; ++i) v[j][i] = *(const u32x4*)(hb + (size_t)(row0 + 8 * j) * DM + i * 512 + lane * 8);
#pragma unroll
        for (int j = 0; j < R; ++j) {
            f32x4 x[2][2]; float ss = 0.f;
#pragma unroll
            for (int i = 0; i < 2; ++i) { x[i][0] = (f32x4){bf_lo(v[j][i].x), bf_hi(v[j][i].x), bf_lo(v[j][i].y), bf_hi(v[j][i].y)}; x[i][1] = (f32x4){bf_lo(v[j][i].z), bf_hi(v[j][i].z), bf_lo(v[j][i].w), bf_hi(v[j][i].w)};
                ss += x[i][0][0] * x[i][0][0] + x[i][0][1] * x[i][0][1] + x[i][0][2] * x[i][0][2] + x[i][0][3] * x[i][0][3] + x[i][1][0] * x[i][1][0] + x[i][1][1] * x[i][1][1] + x[i][1][2] * x[i][1][2] + x[i][1][3] * x[i][1][3]; }
#pragma unroll
            for (int o = 32; o >= 1; o >>= 1) ss += __shfl_xor(ss, o);
            const float r = rsqrtf(ss * (1.0f / 1024.0f) + 1e-6f);
#pragma unroll
            for (int i = 0; i < 2; ++i) { float* o = out + (size_t)(row0 + 8 * j) * DM + i * 512 + lane * 8; *(f32x4*)(o) = (x[i][0] * r) * gg[i][0]; *(f32x4*)(o + 4) = (x[i][1] * r) * gg[i][1]; }
        }
    }
}

struct RetStep { size_t tok0; size_t NT; const bf16_t* vt; const bf16_t* kz; bool isctx; };
__device__ __forceinline__ RetStep ret_step(const Params& p, int step, int b, int dir) {
    RetStep r;
    r.isctx = step < 2;
    if (r.isctx) { const int ci = dir ? 1 - step : step; r.tok0 = (size_t)b * 256 + ci * 128; r.NT = MC; r.vt = (const bf16_t*)(p.ws + OFF_VTC); r.kz = (const bf16_t*)(p.ws + OFF_KTZC); }
    else { const int s = step - 2; const int ci = dir ? 15 - s : s; r.tok0 = (size_t)b * 2048 + ci * 128; r.NT = MX; r.vt = (const bf16_t*)(p.ws + OFF_VT); r.kz = (const bf16_t*)(p.ws + OFF_KTZ); }
    return r;
}
__device__ __forceinline__ void retention_item(LAS unsigned char* lds, const Params& p, int item) {
    int tid_ = threadIdx.x; asm volatile("" : "+v"(tid_));
    const int tid = tid_, wid = __builtin_amdgcn_readfirstlane(tid >> 6), lane = tid & 63, fr = lane & 15, fq = lane >> 4;
    const int b = item >> 3, h = (item >> 1) & 3, dir = item & 1;
    const float l2g = p.ret_log_decay[dir * 4 + h] * 1.4426950408889634f;
    const float decayC = exp2f(128.0f * l2g);
    LAS bf16_t* Ks = (LAS bf16_t*)lds;
    LAS bf16_t* Vts = Ks + 128 * 80;
    LAS bf16_t* Kzs = Vts + 128 * 136;
    LAS bf16_t* Sts = Kzs + 64 * 136;
    const bf16_t* P = (const bf16_t*)(p.ws + OFF_P);
    bf16_t* CAT = (bf16_t*)(p.ws + OFF_A);
    const int c = 16 * wid + fr;
    const float xi = exp2f((float)(dir ? (128 - c) : (c + 1)) * l2g);
    f32x4 accSt[4];
#pragma unroll
    for (int db = 0; db < 4; ++db) accSt[db] = (f32x4){0.f, 0.f, 0.f, 0.f};
    u32x4 pk[2], pv[4], pz[2]; bf16x8 pq[2]; u32x2 pg[8];
#pragma unroll
    for (int q = 0; q < 2; ++q) { pk[q] = (u32x4){0u, 0u, 0u, 0u}; pq[q] = __builtin_bit_cast(bf16x8, pk[q]); }
#pragma unroll
    for (int q = 0; q < 8; ++q) pg[q] = (u32x2){0u, 0u};
    {   const RetStep r = ret_step(p, 0, b, dir);
#pragma unroll
        for (int q = 0; q < 4; ++q) { const int pc = tid + q * 512, row = pc >> 4, seg = pc & 15; pv[q] = *(const u32x4*)(r.vt + (size_t)(128 * h + row) * r.NT + r.tok0 + seg * 8); }
#pragma unroll
        for (int q = 0; q < 2; ++q) { const int pc = tid + q * 512, row = pc >> 4, seg = pc & 15; pz[q] = *(const u32x4*)(r.kz + (size_t)(dir * 256 + 64 * h + row) * r.NT + r.tok0 + seg * 8); }
    }
    for (int step = 0; step < 18; ++step) {
        const RetStep cur = ret_step(p, step, b, dir);
        if (!cur.isctx) {
#pragma unroll
            for (int q = 0; q < 2; ++q) { const int pc = tid + q * 512, row = pc >> 3, seg = pc & 7; *(LAS u32x4*)(Ks + row * 80 + seg * 8) = pk[q]; }
        }
#pragma unroll
        for (int q = 0; q < 4; ++q) { const int pc = tid + q * 512, row = pc >> 4, seg = pc & 15; *(LAS u32x4*)(Vts + row * 136 + seg * 8) = pv[q]; }
#pragma unroll
        for (int q = 0; q < 2; ++q) { const int pc = tid + q * 512, row = pc >> 4, seg = pc & 15; *(LAS u32x4*)(Kzs + row * 136 + seg * 8) = pz[q]; }
        bf16x8 bq[2]; bq[0] = pq[0]; bq[1] = pq[1];
        if (step + 1 < 18) {
            const RetStep nx = ret_step(p, step + 1, b, dir);
            if (!nx.isctx) {
#pragma unroll
                for (int q = 0; q < 2; ++q) { const int pc = tid + q * 512, row = pc >> 3, seg = pc & 7; pk[q] = *(const u32x4*)(P + (nx.tok0 + row) * PW + 256 + 64 * h + seg * 8); }
                const bf16_t* qrow = P + (nx.tok0 + c) * PW + 64 * h + 8 * fq;
                pq[0] = *(const bf16x8*)(qrow); pq[1] = *(const bf16x8*)(qrow + 32);
            }
#pragma unroll
            for (int q = 0; q < 4; ++q) { const int pc = tid + q * 512, row = pc >> 4, seg = pc & 15; pv[q] = *(const u32x4*)(nx.vt + (size_t)(128 * h + row) * nx.NT + nx.tok0 + seg * 8); }
#pragma unroll
            for (int q = 0; q < 2; ++q) { const int pc = tid + q * 512, row = pc >> 4, seg = pc & 15; pz[q] = *(const u32x4*)(nx.kz + (size_t)(dir * 256 + 64 * h + row) * nx.NT + nx.tok0 + seg * 8); }
            if (step == 1) {
                const bf16_t* grow = P + (nx.tok0 + c) * PW + 512 + dir * 512 + 128 * h + 4 * fq;
#pragma unroll
                for (int eb = 0; eb < 8; ++eb) pg[eb] = *(const u32x2*)(grow + 16 * eb);
            }
        }
        __syncthreads();
        if (!cur.isctx) {
            bf16x8 qx[2];
#pragma unroll
            for (int s = 0; s < 2; ++s) { const u32x4 raw = __builtin_bit_cast(u32x4, bq[s]); u32x4 o;
                o.x = cvt_pk_bf16(bf_lo(raw.x) * xi, bf_hi(raw.x) * xi); o.y = cvt_pk_bf16(bf_lo(raw.y) * xi, bf_hi(raw.y) * xi);
                o.z = cvt_pk_bf16(bf_lo(raw.z) * xi, bf_hi(raw.z) * xi); o.w = cvt_pk_bf16(bf_lo(raw.w) * xi, bf_hi(raw.w) * xi);
                qx[s] = __builtin_bit_cast(bf16x8, o); }
            bf16x8 pf[4];
#pragma unroll
            for (int ks = 0; ks < 4; ++ks) {
                const bool live = dir ? (2 * ks + 1 >= wid) : (2 * ks <= wid);
                u32x4 o = {0u, 0u, 0u, 0u};
                if (live) {
                    f32x4 sc[2];
                    bf16x8 ka[2][2];
#pragma unroll
                    for (int q = 0; q < 2; ++q)
#pragma unroll
                        for (int s = 0; s < 2; ++s) ka[q][s] = *(const LAS bf16x8*)(Ks + (16 * (2 * ks + q) + fr) * 80 + 32 * s + 8 * fq);
                    __builtin_amdgcn_sched_barrier(0);
                    __builtin_amdgcn_s_setprio(1);
#pragma unroll
                    for (int q = 0; q < 2; ++q) { sc[q] = (f32x4){0.f, 0.f, 0.f, 0.f};
#pragma unroll
                        for (int s = 0; s < 2; ++s) sc[q] = __builtin_amdgcn_mfma_f32_16x16x32_bf16(ka[q][s], bq[s], sc[q], 0, 0, 0); }
                    __builtin_amdgcn_s_setprio(0);
#pragma unroll
                    for (int q = 0; q < 2; ++q) { const int mb = 2 * ks + q;
#pragma unroll
                        for (int r = 0; r < 4; ++r) { const int m = 16 * mb + 4 * fq + r; const int diff = dir ? (m - c) : (c - m); sc[q][r] = diff >= 0 ? sc[q][r] * __builtin_amdgcn_exp2f((float)diff * l2g) : 0.f; }
                    }
                    o.x = cvt_pk_bf16(sc[0][0], sc[0][1]); o.y = cvt_pk_bf16(sc[0][2], sc[0][3]); o.z = cvt_pk_bf16(sc[1][0], sc[1][1]); o.w = cvt_pk_bf16(sc[1][2], sc[1][3]);
                }
                pf[ks] = __builtin_bit_cast(bf16x8, o);
            }
            f32x4 accO[8];
#pragma unroll
            for (int eb = 0; eb < 8; ++eb) accO[eb] = (f32x4){0.f, 0.f, 0.f, 0.f};
#pragma unroll
            for (int s = 0; s < 2; ++s) {
                bf16x8 sa[8];
#pragma unroll
                for (int eb = 0; eb < 8; ++eb) sa[eb] = *(const LAS bf16x8*)(Sts + (16 * eb + fr) * 80 + 32 * s + 8 * fq);
                __builtin_amdgcn_sched_barrier(0);
                __builtin_amdgcn_s_setprio(1);
#pragma unroll
                for (int eb = 0; eb < 8; ++eb) accO[eb] = __builtin_amdgcn_mfma_f32_16x16x32_bf16(sa[eb], qx[s], accO[eb], 0, 0, 0);
                __builtin_amdgcn_s_setprio(0);
                __builtin_amdgcn_sched_barrier(0);
            }
#pragma unroll
            for (int ks = 0; ks < 4; ++ks) {
                const bool live = dir ? (2 * ks + 1 >= wid) : (2 * ks <= wid);
                if (live) {
                    u32x4 va[8];
#pragma unroll
                    for (int eb = 0; eb < 8; ++eb) {
                        const u32x2 lo = *(const LAS u32x2*)(Vts + (16 * eb + fr) * 136 + 32 * ks + 4 * fq), hi = *(const LAS u32x2*)(Vts + (16 * eb + fr) * 136 + 32 * ks + 16 + 4 * fq);
                        va[eb] = (u32x4){lo.x, lo.y, hi.x, hi.y};
                    }
                    __builtin_amdgcn_sched_barrier(0);
                    __builtin_amdgcn_s_setprio(1);
#pragma unroll
                    for (int eb = 0; eb < 8; ++eb) accO[eb] = __builtin_amdgcn_mfma_f32_16x16x32_bf16(__builtin_bit_cast(bf16x8, va[eb]), pf[ks], accO[eb], 0, 0, 0);
                    __builtin_amdgcn_s_setprio(0);
                    __builtin_amdgcn_sched_barrier(0);
                }
            }
            float sm = 0.f;
#pragma unroll
            for (int eb = 0; eb < 8; ++eb) sm += (accO[eb][0] + accO[eb][1]) + (accO[eb][2] + accO[eb][3]);
            sm += __shfl_xor(sm, 16); sm += __shfl_xor(sm, 32);
            const float mean = sm * (1.0f / 128.0f);
            float vq = 0.f;
#pragma unroll
            for (int eb = 0; eb < 8; ++eb) { const f32x4 d = accO[eb] - mean; vq += (d[0] * d[0] + d[1] * d[1]) + (d[2] * d[2] + d[3] * d[3]); }
            vq += __shfl_xor(vq, 16); vq += __shfl_xor(vq, 32);
            const float rstd = rsqrtf(vq * (1.0f / 128.0f) + 1e-6f);
            bf16_t* yrow = CAT + (cur.tok0 + c) * CATW + dir * 512 + 128 * h + 4 * fq;
#pragma unroll
            for (int eb = 0; eb < 8; ++eb) {
                const u32x2 gr = pg[eb];
                const f32x4 y = (accO[eb] - mean) * rstd;
                u32x2 w; w.x = cvt_pk_bf16(bf_lo(gr.x) * y[0], bf_hi(gr.x) * y[1]); w.y = cvt_pk_bf16(bf_lo(gr.y) * y[2], bf_hi(gr.y) * y[3]);
                *(u32x2*)(yrow + 16 * eb) = w;
            }
            if (step + 1 < 18) {
                const RetStep nx = ret_step(p, step + 1, b, dir);
                const bf16_t* grow = P + (nx.tok0 + c) * PW + 512 + dir * 512 + 128 * h + 4 * fq;
#pragma unroll
                for (int eb = 0; eb < 8; ++eb) pg[eb] = *(const u32x2*)(grow + 16 * eb);
            }
        }
#pragma unroll
        for (int db = 0; db < 4; ++db) accSt[db] = accSt[db] * decayC;
#pragma unroll
        for (int kh = 0; kh < 2; ++kh) {
            bf16x8 a[2], bb[2][4];
#pragma unroll
            for (int q = 0; q < 2; ++q) { const int ks = 2 * kh + q; a[q] = *(const LAS bf16x8*)(Vts + (16 * wid + fr) * 136 + 32 * ks + 8 * fq);
#pragma unroll
                for (int db = 0; db < 4; ++db) bb[q][db] = *(const LAS bf16x8*)(Kzs + (16 * db + fr) * 136 + 32 * ks + 8 * fq); }
            __builtin_amdgcn_sched_barrier(0);
            __builtin_amdgcn_s_setprio(1);
#pragma unroll
            for (int q = 0; q < 2; ++q)
#pragma unroll
                for (int db = 0; db < 4; ++db) accSt[db] = __builtin_amdgcn_mfma_f32_16x16x32_bf16(a[q], bb[q][db], accSt[db], 0, 0, 0);
            __builtin_amdgcn_s_setprio(0);
            __builtin_amdgcn_sched_barrier(0);
        }
        __syncthreads();
#pragma unroll
        for (int db = 0; db < 4; ++db)
#pragma unroll
            for (int r = 0; r < 4; ++r) Sts[(16 * wid + 4 * fq + r) * 80 + 16 * db + fr] = (bf16_t)(cvt_pk_bf16(accSt[db][r], 0.f) & 0xffffu);
    }
    __syncthreads();
}

#define XB_TMO      128
#define XB_XCNT(j)  (256  + 64 * (j))
#define XB_XSUB(j)  (1280 + 64 * (j))
#define XB_XGEN(j)  (2304 + 64 * (j))
#define XB_TOP      3328
#define XB_TOPGEN   3392
#define XCD_BAR_WORDS 3456
#define XB_SPIN_CAP (1u << 18)
__device__ __forceinline__ unsigned xb_ld(unsigned* p)              { return __hip_atomic_load(p, __ATOMIC_RELAXED, __HIP_MEMORY_SCOPE_AGENT); }
__device__ __forceinline__ unsigned xb_add(unsigned* p, unsigned v) { return __hip_atomic_fetch_add(p, v, __ATOMIC_RELAXED, __HIP_MEMORY_SCOPE_AGENT); }
__device__ __forceinline__ unsigned xb_xcc_id() { return (unsigned)__builtin_amdgcn_s_getreg((3 << 11) | 20) & 0xFu; }
#define XB_SPIN(cond, bar) do { unsigned _sp = 0; while (cond) { __builtin_amdgcn_s_sleep(1); \
    if ((++_sp & 255u) == 0u) { if (xb_ld(&(bar)[XB_TMO])) break; if (_sp > XB_SPIN_CAP) { atomicAdd(&(bar)[XB_TMO], 1u); break; } } } } while (0)
struct XcdBarrier { unsigned* bar; unsigned x; volatile LAS unsigned* st; };
__device__ __forceinline__ XcdBarrier xcd_barrier_post(unsigned* bar, volatile LAS unsigned* st) {
    XcdBarrier b; b.bar = bar; b.x = xb_xcc_id(); b.st = st;
    if (threadIdx.x == 0) (void)xb_add(&bar[XB_XCNT(b.x)], 1u);
    return b;
}
__device__ __forceinline__ void xcd_barrier_complete(unsigned* bar, unsigned x, unsigned& nloc, unsigned& nx) {
    const unsigned G = gridDim.x * gridDim.y * gridDim.z;
    unsigned sum, cnt, mine, sp = 0u;
    for (;;) {
        sum = 0u; cnt = 0u; mine = 0u;
#pragma unroll
        for (unsigned j = 0; j < 16; ++j) { const unsigned c = xb_ld(&bar[XB_XCNT(j)]); sum += c; cnt += (c > 0u) ? 1u : 0u; mine = (j == x) ? c : mine; }
        if (sum == G) break;
        __builtin_amdgcn_s_sleep(1);
        if ((++sp & 255u) == 0u) { if (xb_ld(&bar[XB_TMO])) break; if (sp > XB_SPIN_CAP) { atomicAdd(&bar[XB_TMO], 1u); break; } }
    }
    nloc = mine > 0u ? mine : 1u; nx = cnt > 0u ? cnt : 1u;
}
__device__ __forceinline__ void xcd_barrier(const XcdBarrier& b) {
    asm volatile("s_waitcnt vmcnt(0)" ::: "memory");
    __syncthreads();
    if (threadIdx.x == 0) {
        unsigned* bar = b.bar;
        __builtin_amdgcn_s_waitcnt(0);
        unsigned nloc = b.st[0], nx = b.st[1];
        if (nloc == 0u) { xcd_barrier_complete(bar, b.x, nloc, nx); b.st[0] = nloc; b.st[1] = nx; }
        const unsigned old = xb_add(&bar[XB_XSUB(b.x)], 1u);
        const unsigned gen = old / nloc;
        if (old + 1u == (gen + 1u) * nloc) {
            __builtin_amdgcn_fence(__ATOMIC_RELEASE, "agent");
            asm volatile("s_waitcnt vmcnt(0)" ::: "memory");
            const unsigned og = xb_add(&bar[XB_TOP], 1u);
            const unsigned tg = og / nx;
            if (og + 1u == (tg + 1u) * nx) xb_add(&bar[XB_TOPGEN], 1u);
            else XB_SPIN(xb_ld(&bar[XB_TOPGEN]) == tg, bar);
            __builtin_amdgcn_fence(__ATOMIC_ACQUIRE, "agent");
            xb_add(&bar[XB_XGEN(b.x)], 1u);
            asm volatile("s_waitcnt vmcnt(0)" ::: "memory");
        } else {
            XB_SPIN(xb_ld(&bar[XB_XGEN(b.x)]) == gen, bar);
            __builtin_amdgcn_fence(__ATOMIC_ACQUIRE, "agent");
            asm volatile("s_waitcnt vmcnt(0)" ::: "memory");
        }
    }
    __syncthreads();
}

#define GRID_SYNC() do { asm volatile("s_waitcnt vmcnt(0)" ::: "memory"); __syncthreads(); cg::this_grid().sync(); } while (0)
__global__ void __launch_bounds__(512, 2) fwd_megakernel(Params p) {
    extern __shared__ __attribute__((aligned(16))) unsigned char shm[];
    LAS unsigned char* lds = (LAS unsigned char*)shm;
    unsigned char* ws = p.ws;
    const float* mod = (const float*)(ws + OFF_MOD);
    bf16_t* Abuf = (bf16_t*)(ws + OFF_A);
    bf16_t* Hbuf = (bf16_t*)(ws + OFF_H);
    float* hc = (float*)(ws + OFF_HC);

    unsigned* barw = (unsigned*)(ws + OFF_BAR);
    if (blockIdx.x == 0) for (int i = threadIdx.x; i < XCD_BAR_WORDS; i += 512) barw[i] = 0u;
    volatile LAS unsigned* bst = (volatile LAS unsigned*)(lds + 131072);
    if (threadIdx.x < 4) bst[threadIdx.x] = 0u;
    phase_prep(shm, p, 0, (int)blockIdx.x, (int)gridDim.x);
    GRID_SYNC();
    const XcdBarrier xb = xcd_barrier_post(barw, bst);
    phase_norm_mod<8>(p.x, p.ctx, MT, p.norm_ffn1, mod, 0 * DM, 1 * DM, Abuf);
    xcd_barrier(xb);
    { EpiSwiGLU e; e.H = Hbuf; run_gemm(lds, Abuf, (const bf16_t*)(ws + OFF_WB13_1), MT, 5632, 1024, e); }
    xcd_barrier(xb);
    bf16_t* h1b = (bf16_t*)p.out;
    { EpiResidBfC e; e.res_x = p.x; e.res_c = p.ctx; e.hb = h1b; e.gate = mod + 2 * DM; e.gs = 0.5f; run_gemm(lds, Hbuf, (const bf16_t*)(ws + OFF_WB2_1), MT, 1024, DFF, e, 0, 1); }
    { const int rem = (int)((MT / 256 * 4) % gridDim.x);
      if (rem == 0) phase_prep(shm, p, 1, (int)blockIdx.x, (int)gridDim.x);
      else if ((int)blockIdx.x >= rem) phase_prep(shm, p, 1, (int)blockIdx.x - rem, (int)gridDim.x - rem); }
    xcd_barrier(xb);
    phase_norm_mix_pairs_bf(h1b, p.norm_mix, mod, 3 * DM, 4 * DM, Abuf, (bf16_t*)(ws + OFF_A2E), (bf16_t*)(ws + OFF_A2O));
    phase_norm_mod_bf<4>(h1b, MT, p.norm_mix, mod, 3 * DM, 4 * DM, Abuf, MX);
    xcd_barrier(xb);
    phase_ych(Abuf, (const bf16_t*)(ws + OFF_WSW) + (size_t)768 * 1024, (float*)(ws + OFF_YCH));
    { EpiInProj e; e.P = (bf16_t*)(ws + OFF_P); e.ropeA = (const float*)(ws + OFF_ROPE); e.KTZ = (bf16_t*)(ws + OFF_KTZ); e.lgd = p.ret_log_decay; run_gemm(lds, Abuf, (const bf16_t*)(ws + OFF_WBIN), MX, 1536, 1024, e); }
    { EpiSwapVF e; e.VT = (bf16_t*)(ws + OFF_VT); e.NT = MX;
      run_gemm(lds, (const bf16_t*)(ws + OFF_WSW) + (size_t)256 * 1024, Abuf, 512, MX, 1024, e); }
    { EpiSwapF e; e.YT = (bf16_t*)(ws + OFF_YT); e.part = 0;
      run_gemm(lds, (const bf16_t*)(ws + OFF_WSW) + (size_t)768 * 1024, (const bf16_t*)(ws + OFF_A2E), 512, 32768, 1024, e); }
    { EpiSwapF e; e.YT = (bf16_t*)(ws + OFF_YT); e.part = 1;
      run_gemm(lds, (const bf16_t*)(ws + OFF_WSW) + (size_t)1280 * 1024, (const bf16_t*)(ws + OFF_A2O), 512, 32768, 1024, e); }
    { EpiSwapK<false> e; e.KTZ = (bf16_t*)(ws + OFF_KTZC); e.ropeA = (const float*)(ws + OFF_ROPE); e.lgd = p.ret_log_decay; e.NT = MC;
      run_gemm(lds, (const bf16_t*)(ws + OFF_WSW), Abuf + (size_t)MX * DM, 256, MC, 1024, e, 256 - 32); }
    { EpiSwapVF e; e.VT = (bf16_t*)(ws + OFF_VTC); e.NT = MC;
      run_gemm(lds, (const bf16_t*)(ws + OFF_WSW) + (size_t)256 * 1024, Abuf + (size_t)MX * DM, 512, MC, 1024, e, 256 - 96); }
    xcd_barrier(xb);
    for (int item = blockIdx.x; item < 256; item += gridDim.x) retention_item(lds, p, item);
    { EpiFour e; e.CAT = Abuf; e.YCH = (const float*)(ws + OFF_YCH); run_gemm(lds, (const bf16_t*)(ws + OFF_TT), (const bf16_t*)(ws + OFF_YT), 2048, 16384, 2048, e); }
    xcd_barrier(xb);
    { EpiResidBfBf e; e.res_b = h1b; e.hb = (bf16_t*)(ws + OFF_H2B); e.gate = mod + 5 * DM; e.gs = 1.0f; run_gemm(lds, Abuf, (const bf16_t*)(ws + OFF_WOUT3), MX, 1024, 1536, e); }
    xcd_barrier(xb);
    phase_norm_mod_bf<8>((const bf16_t*)(ws + OFF_H2B), MX, p.norm_ffn2, mod, 6 * DM, 7 * DM, Abuf);
    xcd_barrier(xb);
    { EpiSwiGLU e; e.H = Hbuf; run_gemm(lds, Abuf, (const bf16_t*)(ws + OFF_WB13_2), MX, 5632, 1024, e); }
    xcd_barrier(xb);
    { EpiResidBfBf e; e.res_b = (const bf16_t*)(ws + OFF_H2B); e.hb = Abuf; e.gate = mod + 8 * DM; e.gs = 0.5f; run_gemm(lds, Hbuf, (const bf16_t*)(ws + OFF_WB2_2), MX, 1024, DFF, e, 0, 1); }
    xcd_barrier(xb);
    phase_final_norm(Abuf, p.out, p.norm_final);
}

extern "C" void kernel_launch(void* const* d_in, const int* in_sizes, int n_in, void* d_out, int out_size, void* d_ws, size_t ws_size, hipStream_t stream) {
    static int grid_blocks = 0;
    if (grid_blocks == 0) {
        if (n_in != 17 || ws_size < WS_END) { fprintf(stderr, "kernel_launch: unexpected n_in %d or ws_size %zu (< %zu)\n", n_in, ws_size, (size_t)WS_END); grid_blocks = -1; return; }
        int dev = 0, cus = 0, per_cu = 0;
        hipGetDevice(&dev);
        hipDeviceGetAttribute(&cus, hipDeviceAttributeMultiprocessorCount, dev);
        hipFuncSetAttribute((const void*)fwd_megakernel, hipFuncAttributeMaxDynamicSharedMemorySize, LDS_BYTES);
        hipOccupancyMaxActiveBlocksPerMultiprocessor(&per_cu, (const void*)fwd_megakernel, 512, LDS_BYTES);
        if (per_cu < 1) per_cu = 1;
        grid_blocks = cus * per_cu;
        fprintf(stderr, "kernel_launch: cus %d per_cu %d grid %d ws %zu need %zu\n", cus, per_cu, grid_blocks, ws_size, (size_t)WS_END);
    }
    if (grid_blocks < 0) return;
    Params p{};
    p.x = (const float*)d_in[0]; p.c = (const float*)d_in[1]; p.ctx = (const float*)d_in[2]; p.c_ctx = (const float*)d_in[3];
    p.w_mod = (const float*)d_in[4]; p.b_mod = (const float*)d_in[5]; p.norm_ffn1 = (const float*)d_in[6]; p.w13_1 = (const float*)d_in[7]; p.w2_1 = (const float*)d_in[8];
    p.norm_mix = (const float*)d_in[9]; p.w_in = (const float*)d_in[10]; p.ret_log_decay = (const float*)d_in[11]; p.w_out = (const float*)d_in[12];
    p.norm_ffn2 = (const float*)d_in[13]; p.w13_2 = (const float*)d_in[14]; p.w2_2 = (const float*)d_in[15]; p.norm_final = (const float*)d_in[16];
    p.out = (float*)d_out; p.ws = (unsigned char*)d_ws;
    void* args[] = {&p};
    hipError_t e = hipLaunchCooperativeKernel((const void*)fwd_megakernel, dim3(grid_blocks), dim3(512), args, LDS_BYTES, stream);
    if (e != hipSuccess) fprintf(stderr, "cooperative launch failed: %s (grid %d)\n", hipGetErrorString(e), grid_blocks);
}
```

```cpp
#include <hip/hip_runtime.h>
#include <hip/hip_cooperative_groups.h>
#include <cstdio>
namespace cg = cooperative_groups;

#define LAS __attribute__((address_space(3)))
typedef unsigned short bf16_t;
typedef short bf16x8 __attribute__((ext_vector_type(8)));
typedef short bf16x4 __attribute__((ext_vector_type(4)));
typedef float f32x4 __attribute__((ext_vector_type(4)));
typedef unsigned u32x4 __attribute__((ext_vector_type(4)));
typedef unsigned u32x2 __attribute__((ext_vector_type(2)));

constexpr int MX = 65536, MC = 8192, MT = MX + MC, DM = 1024, DFF = 2816, NMOD = 9216;
constexpr int PW = 1536;
constexpr int CATW = 1536;

constexpr size_t SZ_WB13 = (size_t)5632 * 1024 * 2, SZ_WB2 = (size_t)1024 * 2816 * 2;
constexpr size_t OFF_WB13_1 = 0;
constexpr size_t OFF_WB2_1 = OFF_WB13_1 + SZ_WB13;
constexpr size_t OFF_WB13_2 = OFF_WB2_1 + SZ_WB2;
constexpr size_t OFF_WB2_2 = OFF_WB13_2 + SZ_WB13;
constexpr size_t OFF_WBIN = OFF_WB2_2 + SZ_WB2;
constexpr size_t OFF_WSW = OFF_WBIN + (size_t)1536 * 1024 * 2;
constexpr size_t OFF_WOUT3 = OFF_WSW + (size_t)1792 * 1024 * 2;
constexpr size_t OFF_TT = OFF_WOUT3 + (size_t)1024 * 1536 * 2;
constexpr size_t OFF_MOD = OFF_TT + (size_t)2048 * 2048 * 2;
constexpr size_t OFF_ROPE = OFF_MOD + (size_t)33 * 9216 * 4;
constexpr size_t OFF_YCH = OFF_ROPE + 16384;
constexpr size_t OFF_BAR = OFF_YCH + 65536;
constexpr size_t OFF_A = (size_t)80 << 20;
constexpr size_t SZ_A = (size_t)MX * CATW * 2;
constexpr size_t OFF_H = OFF_A + SZ_A;
constexpr size_t SZ_H = (size_t)MT * DFF * 2;
constexpr size_t OFF_P = OFF_H;
constexpr size_t OFF_YT = OFF_P + (size_t)MX * PW * 2;
constexpr size_t OFF_A2E = OFF_YT + (size_t)16384 * 2048 * 2;
constexpr size_t OFF_A2O = OFF_A2E + (size_t)32768 * 1024 * 2;
constexpr size_t OFF_HC = OFF_H + SZ_H;
constexpr size_t OFF_KTZ = OFF_HC + (size_t)MC * DM * 4;
constexpr size_t OFF_VT = OFF_KTZ + (size_t)2 * 256 * MX * 2;
constexpr size_t OFF_KTZC = OFF_VT + (size_t)512 * MX * 2;
constexpr size_t OFF_VTC = OFF_KTZC + (size_t)2 * 256 * MC * 2;
constexpr size_t OFF_H2B = OFF_KTZ;
constexpr size_t WS_END = OFF_VTC + (size_t)512 * MC * 2;
static_assert(OFF_BAR + 3456 * 4 <= OFF_A, "weights region overflow");
static_assert(OFF_A2O + (size_t)32768 * 1024 * 2 <= OFF_HC, "mix buffers overflow H region");

constexpr int XCD_BAR_WORDS_C = 3456;
constexpr int LDS_BYTES = 131072 + 16;

struct Params {
    const float *x, *c, *ctx, *c_ctx, *w_mod, *b_mod, *norm_ffn1, *w13_1, *w2_1, *norm_mix, *w_in, *ret_log_decay, *w_out, *norm_ffn2, *w13_2, *w2_2, *norm_final;
    float* out; unsigned char* ws;
};

__device__ __forceinline__ unsigned cvt_pk_bf16(float lo, float hi) { unsigned r; asm volatile("v_cvt_pk_bf16_f32 %0, %1, %2" : "=v"(r) : "v"(lo), "v"(hi)); return r; }
__device__ __forceinline__ float bf_lo(unsigned u) { return __uint_as_float(u << 16); }
__device__ __forceinline__ float bf_hi(unsigned u) { return __uint_as_float(u & 0xffff0000u); }
__device__ __forceinline__ float silu_f(float a) { return a * __builtin_amdgcn_rcpf(1.0f + __expf(-a)); }

namespace pg8 {
constexpr int BM = 256, BK = 64, HALF = 128, HTB = HALF * BK * 2, STAGE_BYTES = 8 * HTB, NXCD = 8, WGM = 8;
__device__ __forceinline__ int lds_byte(int r, int c) { const int st = (r >> 4) * 2 + (c >> 5), rr = r & 15, cc = c & 31, ob = rr * 64 + cc * 2; return st * 1024 + (ob ^ (((ob >> 9) & 1) << 5)); }
__device__ __forceinline__ void stage_rc(int b, int& R, int& C) { const int st = b / 1024, sb = b % 1024, swz = sb ^ (((sb >> 9) & 1) << 5); R = (st >> 1) * 16 + swz / 64; C = (st & 1) * 32 + (swz % 64) / 2; }
__device__ __forceinline__ int perm32(int rho) { const int n = rho >> 4, i = rho & 15; return 8 * (i >> 2) + 4 * n + (i & 3); }
struct Unit { int pm, pn; };
struct Gemm { const bf16_t* A; const bf16_t* Bt; int M, N, K; };
struct StaticOrder {
    int nM, nN, nwg, G, c, rev;
    __device__ void init(int M, int N, int G_, int c_, int rev_ = 0) { nM = M / BM; nN = N / BM; nwg = nM * nN; G = G_; c = c_; rev = rev_; }
    __device__ bool next(int i, Unit& u) const {
        const long L = (long)i * G + c; if (L >= nwg) return false;
        int wgid = rev ? (int)(nwg - 1 - L) : (int)L; { const int q = nwg / NXCD, r = nwg % NXCD, xcd = wgid % NXCD, off = wgid / NXCD; wgid = (xcd < r ? xcd * (q + 1) : r * (q + 1) + (xcd - r) * q) + off; }
        const int nig = WGM * nN, gid = wgid / nig, fm = gid * WGM, gsz = (nM - fm) < WGM ? (nM - fm) : WGM;
        u.pm = fm + ((wgid % nig) % gsz); u.pn = (wgid % nig) / gsz; return true;
    }
};

template <class Epi, class Sched>
__device__ __forceinline__ void gemm_phase(LAS unsigned char* lds, const Gemm g, const Sched& S, const Epi& E) {
    int tid_ = threadIdx.x; asm volatile("" : "+v"(tid_));
    const int tid = tid_, wid = __builtin_amdgcn_readfirstlane(tid >> 6), lane = tid & 63, wr = wid >> 2, wc = wid & 3, fr = lane & 15, fq = lane >> 4;
    const int K = g.K, nt = K / BK;
    unsigned voffA[2], voffB[2];
#pragma unroll
    for (int i = 0; i < 2; ++i) { int R, C; stage_rc(tid * 16 + i * 8192, R, C); const int Rb = Epi::PERM ? ((R & ~31) + perm32(R & 31)) : R;
        voffA[i] = (unsigned)(R * K + C) * 2u; voffB[i] = (unsigned)(Rb * K + C) * 2u; }
    const size_t kstep = (size_t)(BK * 2);
    const size_t hstep = (size_t)HALF * K * 2;
    const size_t tstep = 2 * hstep;
    const unsigned ldsw = (unsigned)wid * 1024u;
    const int aoff = lds_byte(wr * 64 + fr, fq * 8), boff = lds_byte(wc * 32 + fr, fq * 8);
#define PG8_SA(b, h) (((b) * 2 + (h)) * HTB)
#define PG8_SB(b, h) ((4 + (b) * 2 + (h)) * HTB)
#define PG8_STAGE(bufoff, gbase, voff) do { _Pragma("unroll") for (int _i = 0; _i < 2; ++_i) \
        __builtin_amdgcn_global_load_lds((const unsigned*)((const char*)(gbase) + (voff)[_i]), (LAS unsigned*)(lds + (bufoff) + ldsw + _i * 8192), 16, 0, 0); } while (0)
#define PG8_LDA(dst, b, h) do { _Pragma("unroll") for (int m = 0; m < 4; ++m) _Pragma("unroll") for (int k = 0; k < 2; ++k) dst[m][k] = *(const LAS bf16x8*)(lds + PG8_SA(b, h) + aoff + m * 2048 + k * 1024); } while (0)
#define PG8_LDB(dst, b, h) do { _Pragma("unroll") for (int n = 0; n < 2; ++n) _Pragma("unroll") for (int k = 0; k < 2; ++k) dst[n][k] = *(const LAS bf16x8*)(lds + PG8_SB(b, h) + boff + n * 2048 + k * 1024); } while (0)
#define PG8_MMA(ai, bj, At, Bt) do { __builtin_amdgcn_s_setprio(1); _Pragma("unroll") for (int m = 0; m < 4; ++m) _Pragma("unroll") for (int n = 0; n < 2; ++n) _Pragma("unroll") for (int k = 0; k < 2; ++k) \
        acc[ai][bj][m][n] = __builtin_amdgcn_mfma_f32_16x16x32_bf16(Bt[n][k], At[m][k], acc[ai][bj][m][n], 0, 0, 0); __builtin_amdgcn_s_setprio(0); } while (0)
#define PG8_WAIT_V(n) asm volatile("s_waitcnt vmcnt(" #n ")" ::: "memory")
#define PG8_WAIT_L(n) asm volatile("s_waitcnt lgkmcnt(" #n ")" ::: "memory")
#define PG8_BAR __builtin_amdgcn_s_barrier()
#define PG8_SCHED __builtin_amdgcn_sched_barrier(0)
    Unit cur, nxt; int ui = 0;
    if (!S.next(0, cur)) return;
    f32x4 acc[2][2][4][2];
#pragma unroll
    for (int a = 0; a < 2; ++a)
#pragma unroll
        for (int b = 0; b < 2; ++b)
#pragma unroll
            for (int m = 0; m < 4; ++m)
#pragma unroll
                for (int n = 0; n < 2; ++n) acc[a][b][m][n] = (f32x4){0.f, 0.f, 0.f, 0.f};
    bf16x8 At[4][2], B0[2][2], B1[2][2];
    const char* cA = (const char*)g.A + (size_t)cur.pm * tstep; const char* cB = (const char*)g.Bt + (size_t)cur.pn * tstep;
    PG8_STAGE(PG8_SB(0, 0), cB, voffB); PG8_STAGE(PG8_SA(0, 0), cA, voffA); PG8_STAGE(PG8_SB(0, 1), cB + hstep, voffB); PG8_STAGE(PG8_SA(0, 1), cA + hstep, voffA);
    if (wr == 1) PG8_BAR;
    PG8_WAIT_V(4); PG8_BAR;
    PG8_STAGE(PG8_SB(1, 0), cB + kstep, voffB); PG8_STAGE(PG8_SA(1, 0), cA + kstep, voffA); PG8_STAGE(PG8_SB(1, 1), cB + hstep + kstep, voffB);
    PG8_WAIT_V(6); PG8_BAR;
    for (;;) {
        const bool has_next = S.next(ui + 1, nxt);
        const char* nA = has_next ? (const char*)g.A + (size_t)nxt.pm * tstep : cA; const char* nB = has_next ? (const char*)g.Bt + (size_t)nxt.pn * tstep : cB;
        for (int t = 0; t < nt; t += 2) {
            const bool last = (t == nt - 2);
            const char* a1 = cA + (size_t)(t + 1) * kstep;
            const char* a2 = last ? nA : cA + (size_t)(t + 2) * kstep; const char* b2 = last ? nB : cB + (size_t)(t + 2) * kstep;
            const char* a3 = a2 + kstep; const char* b3 = b2 + kstep;
            PG8_LDB(B0, 0, 0); PG8_SCHED; PG8_LDA(At, 0, 0); PG8_STAGE(PG8_SA(1, 1), a1 + hstep, voffA);
            PG8_WAIT_L(8); PG8_BAR; PG8_WAIT_L(0); PG8_MMA(0, 0, At, B0); PG8_BAR; PG8_SCHED;
            PG8_LDB(B1, 0, 1); PG8_STAGE(PG8_SB(0, 0), b2, voffB);
            PG8_BAR; PG8_WAIT_L(0); PG8_MMA(0, 1, At, B1); PG8_BAR;
            PG8_LDA(At, 0, 1); PG8_STAGE(PG8_SA(0, 0), a2, voffA);
            PG8_BAR; PG8_WAIT_L(0); PG8_MMA(1, 0, At, B0); PG8_BAR; PG8_SCHED;
            PG8_STAGE(PG8_SB(0, 1), b2 + hstep, voffB);
            PG8_WAIT_V(6); PG8_BAR; PG8_MMA(1, 1, At, B1); PG8_BAR;
            PG8_LDB(B0, 1, 0); PG8_SCHED; PG8_LDA(At, 1, 0); PG8_STAGE(PG8_SA(0, 1), a2 + hstep, voffA);
            PG8_WAIT_L(8); PG8_BAR; PG8_WAIT_L(0); PG8_MMA(0, 0, At, B0); PG8_BAR; PG8_SCHED;
            PG8_LDB(B1, 1, 1); PG8_STAGE(PG8_SB(1, 0), b3, voffB);
            PG8_BAR; PG8_WAIT_L(0); PG8_MMA(0, 1, At, B1); PG8_BAR;
            PG8_LDA(At, 1, 1); PG8_STAGE(PG8_SA(1, 0), a3, voffA);
            PG8_BAR; PG8_WAIT_L(0); PG8_MMA(1, 0, At, B0); PG8_BAR; PG8_SCHED;
            PG8_STAGE(PG8_SB(1, 1), b3 + hstep, voffB);
            PG8_WAIT_V(6); PG8_BAR; PG8_MMA(1, 1, At, B1); PG8_BAR;
        }
        E(acc, cur, wr, wc, fr, fq);
        if (!has_next) break;
#pragma unroll
        for (int a = 0; a < 2; ++a)
#pragma unroll
            for (int b = 0; b < 2; ++b)
#pragma unroll
                for (int m = 0; m < 4; ++m)
#pragma unroll
                    for (int n = 0; n < 2; ++n) acc[a][b][m][n] = (f32x4){0.f, 0.f, 0.f, 0.f};
        cur = nxt; cA = nA; cB = nB; ++ui;
    }
    PG8_WAIT_V(0);
    if (wr == 0) PG8_BAR;
    PG8_BAR;
#undef PG8_SA
#undef PG8_SB
#undef PG8_STAGE
#undef PG8_LDA
#undef PG8_LDB
#undef PG8_MMA
#undef PG8_WAIT_V
#undef PG8_WAIT_L
#undef PG8_BAR
#undef PG8_SCHED
}
}
using pg8::Unit;
typedef f32x4 AccT[2][2][4][2];


struct EpiSwiGLU {
    static constexpr bool PERM = true;
    bf16_t* H;
    __device__ __forceinline__ void operator()(const AccT& acc, const Unit& u, int wr, int wc, int fr, int fq) const {
        asm volatile("" : "+v"(fr), "+v"(fq));
        const int row0 = u.pm * 256 + wr * 64 + fr, hc0 = u.pn * 128 + wc * 32 + 8 * fq;
#pragma unroll
        for (int ai = 0; ai < 2; ++ai)
#pragma unroll
            for (int m = 0; m < 4; ++m) {
                const f32x4 a0 = acc[ai][0][m][0], a1 = acc[ai][0][m][1], b0 = acc[ai][1][m][0], b1 = acc[ai][1][m][1];
                u32x4 w;
                w.x = cvt_pk_bf16(silu_f(a0[0]) * b0[0], silu_f(a0[1]) * b0[1]); w.y = cvt_pk_bf16(silu_f(a0[2]) * b0[2], silu_f(a0[3]) * b0[3]);
                w.z = cvt_pk_bf16(silu_f(a1[0]) * b1[0], silu_f(a1[1]) * b1[1]); w.w = cvt_pk_bf16(silu_f(a1[2]) * b1[2], silu_f(a1[3]) * b1[3]);
                *(u32x4*)(H + (size_t)(row0 + ai * 128 + m * 16) * DFF + hc0) = w;
            }
    }
};

struct EpiResid {
    static constexpr bool PERM = false;
    const float* res_x; const float* res_c; float* out_x; float* out_c; const float* gate; float gs;
    __device__ __forceinline__ void operator()(const AccT& acc, const Unit& u, int wr, int wc, int fr, int fq) const {
        asm volatile("" : "+v"(fr), "+v"(fq));
        const int rowt = u.pm * 256; const bool isc = rowt >= MX;
        const int b = isc ? 32 : (rowt >> 11);
        const float* res = isc ? res_c + (size_t)(rowt - MX) * DM : res_x + (size_t)rowt * DM;
        float* out = isc ? out_c + (size_t)(rowt - MX) * DM : out_x + (size_t)rowt * DM;
        const int col0 = u.pn * 256 + wc * 32 + 4 * fq;
        f32x4 gv[2][2];
#pragma unroll
        for (int bj = 0; bj < 2; ++bj)
#pragma unroll
            for (int n = 0; n < 2; ++n) gv[bj][n] = *(const f32x4*)(gate + (size_t)b * NMOD + col0 + bj * 128 + n * 16) * gs;
#pragma unroll
        for (int ai = 0; ai < 2; ++ai) {
            const size_t ro = (size_t)(wr * 64 + fr + ai * 128) * DM + col0;
            f32x4 r[4][2][2];
#pragma unroll
            for (int m = 0; m < 4; ++m)
#pragma unroll
                for (int bj = 0; bj < 2; ++bj)
#pragma unroll
                    for (int n = 0; n < 2; ++n) r[m][bj][n] = *(const f32x4*)(res + ro + (size_t)m * 16 * DM + bj * 128 + n * 16);
#pragma unroll
            for (int m = 0; m < 4; ++m)
#pragma unroll
                for (int bj = 0; bj < 2; ++bj)
#pragma unroll
                    for (int n = 0; n < 2; ++n) *(f32x4*)(out + ro + (size_t)m * 16 * DM + bj * 128 + n * 16) = r[m][bj][n] + gv[bj][n] * acc[ai][bj][m][n];
        }
    }
};

struct EpiResidBf {
    static constexpr bool PERM = true;
    const float* res_x; bf16_t* hb; const float* gate; float gs;
    __device__ __forceinline__ void operator()(const AccT& acc, const Unit& u, int wr, int wc, int fr, int fq) const {
        asm volatile("" : "+v"(fr), "+v"(fq));
        const int rowt = u.pm * 256; const int b = rowt >> 11;
        const float* res = res_x + (size_t)rowt * DM; bf16_t* out = hb + (size_t)rowt * DM;
        const int col0 = u.pn * 256 + wc * 32 + 8 * fq;
        f32x4 gv[2][2];
#pragma unroll
        for (int bj = 0; bj < 2; ++bj)
#pragma unroll
            for (int n = 0; n < 2; ++n) gv[bj][n] = *(const f32x4*)(gate + (size_t)b * NMOD + col0 + bj * 128 + n * 4) * gs;
#pragma unroll
        for (int ai = 0; ai < 2; ++ai) {
            const size_t ro = (size_t)(wr * 64 + fr + ai * 128) * DM + col0;
            f32x4 r[4][2][2];
#pragma unroll
            for (int m = 0; m < 4; ++m)
#pragma unroll
                for (int bj = 0; bj < 2; ++bj)
#pragma unroll
                    for (int n = 0; n < 2; ++n) r[m][bj][n] = *(const f32x4*)(res + ro + (size_t)m * 16 * DM + bj * 128 + n * 4);
#pragma unroll
            for (int m = 0; m < 4; ++m)
#pragma unroll
                for (int bj = 0; bj < 2; ++bj) {
                    const f32x4 h0 = r[m][bj][0] + gv[bj][0] * acc[ai][bj][m][0], h1 = r[m][bj][1] + gv[bj][1] * acc[ai][bj][m][1];
                    u32x4 w; w.x = cvt_pk_bf16(h0[0], h0[1]); w.y = cvt_pk_bf16(h0[2], h0[3]); w.z = cvt_pk_bf16(h1[0], h1[1]); w.w = cvt_pk_bf16(h1[2], h1[3]);
                    *(u32x4*)(out + ro + (size_t)m * 16 * DM + bj * 128) = w;
                }
        }
    }
};

struct EpiResidBfBf {
    static constexpr bool PERM = true;
    const bf16_t* res_b; bf16_t* hb; const float* gate; float gs;
    __device__ __forceinline__ void operator()(const AccT& acc, const Unit& u, int wr, int wc, int fr, int fq) const {
        asm volatile("" : "+v"(fr), "+v"(fq));
        const int rowt = u.pm * 256; const int b = rowt >> 11;
        const bf16_t* res = res_b + (size_t)rowt * DM; bf16_t* out = hb + (size_t)rowt * DM;
        const int col0 = u.pn * 256 + wc * 32 + 8 * fq;
        f32x4 gv[2][2];
#pragma unroll
        for (int bj = 0; bj < 2; ++bj)
#pragma unroll
            for (int n = 0; n < 2; ++n) gv[bj][n] = *(const f32x4*)(gate + (size_t)b * NMOD + col0 + bj * 128 + n * 4) * gs;
        u32x4 r[2][4][2];
#pragma unroll
        for (int ai = 0; ai < 2; ++ai)
#pragma unroll
            for (int m = 0; m < 4; ++m)
#pragma unroll
                for (int bj = 0; bj < 2; ++bj) r[ai][m][bj] = *(const u32x4*)(res + (size_t)(wr * 64 + fr + ai * 128 + m * 16) * DM + col0 + bj * 128);
#pragma unroll
        for (int ai = 0; ai < 2; ++ai)
#pragma unroll
            for (int m = 0; m < 4; ++m)
#pragma unroll
                for (int bj = 0; bj < 2; ++bj) {
                    const u32x4 q = r[ai][m][bj];
                    const f32x4 r0 = {bf_lo(q.x), bf_hi(q.x), bf_lo(q.y), bf_hi(q.y)}, r1 = {bf_lo(q.z), bf_hi(q.z), bf_lo(q.w), bf_hi(q.w)};
                    const f32x4 h0 = r0 + gv[bj][0] * acc[ai][bj][m][0], h1 = r1 + gv[bj][1] * acc[ai][bj][m][1];
                    u32x4 w; w.x = cvt_pk_bf16(h0[0], h0[1]); w.y = cvt_pk_bf16(h0[2], h0[3]); w.z = cvt_pk_bf16(h1[0], h1[1]); w.w = cvt_pk_bf16(h1[2], h1[3]);
                    *(u32x4*)(out + (size_t)(wr * 64 + fr + ai * 128 + m * 16) * DM + col0 + bj * 128) = w;
                }
    }
};

struct EpiResidBfC {
    static constexpr bool PERM = true;
    const float* res_x; const float* res_c; bf16_t* hb; const float* gate; float gs;
    __device__ __forceinline__ void operator()(const AccT& acc, const Unit& u, int wr, int wc, int fr, int fq) const {
        asm volatile("" : "+v"(fr), "+v"(fq));
        const int rowt = u.pm * 256; const bool isc = rowt >= MX; const int b = isc ? 32 : (rowt >> 11);
        const float* res = isc ? res_c + (size_t)(rowt - MX) * DM : res_x + (size_t)rowt * DM; bf16_t* out = hb + (size_t)rowt * DM;
        const int col0 = u.pn * 256 + wc * 32 + 8 * fq;
        f32x4 gv[2][2];
#pragma unroll
        for (int bj = 0; bj < 2; ++bj)
#pragma unroll
            for (int n = 0; n < 2; ++n) gv[bj][n] = *(const f32x4*)(gate + (size_t)b * NMOD + col0 + bj * 128 + n * 4) * gs;
#pragma unroll
        for (int ai = 0; ai < 2; ++ai) {
            const size_t ro = (size_t)(wr * 64 + fr + ai * 128) * DM + col0;
            f32x4 r[4][2][2];
#pragma unroll
            for (int m = 0; m < 4; ++m)
#pragma unroll
                for (int bj = 0; bj < 2; ++bj)
#pragma unroll
                    for (int n = 0; n < 2; ++n) r[m][bj][n] = *(const f32x4*)(res + ro + (size_t)m * 16 * DM + bj * 128 + n * 4);
#pragma unroll
            for (int m = 0; m < 4; ++m)
#pragma unroll
                for (int bj = 0; bj < 2; ++bj) {
                    const f32x4 h0 = r[m][bj][0] + gv[bj][0] * acc[ai][bj][m][0], h1 = r[m][bj][1] + gv[bj][1] * acc[ai][bj][m][1];
                    u32x4 w; w.x = cvt_pk_bf16(h0[0], h0[1]); w.y = cvt_pk_bf16(h0[2], h0[3]); w.z = cvt_pk_bf16(h1[0], h1[1]); w.w = cvt_pk_bf16(h1[2], h1[3]);
                    *(u32x4*)(out + ro + (size_t)m * 16 * DM + bj * 128) = w;
                }
        }
    }
};

struct EpiInProj {
    static constexpr bool PERM = true;
    bf16_t* P; const float* ropeA;
    bf16_t* KTZ; const float* lgd;
    __device__ __forceinline__ void operator()(const AccT& acc, const Unit& u, int wr, int wc, int fr, int fq) const {
        asm volatile("" : "+v"(fr), "+v"(fq));
        const int row0 = u.pm * 256 + wr * 64 + fr, col0 = u.pn * 256 + wc * 32 + 8 * fq;
        const bool rope = u.pn < 2, ktile = u.pn == 1;
        const int i = 4 * (wc & 1) + fq;
#pragma unroll
        for (int ai = 0; ai < 2; ++ai)
#pragma unroll
            for (int m = 0; m < 4; ++m) {
                const int row = row0 + ai * 128 + m * 16;
                f32x4 cs = {1.f, 1.f, 1.f, 1.f}, sn = {0.f, 0.f, 0.f, 0.f};
                if (rope) { const int t = row & 2047; const int pos = (i < 4) ? (t >> 6) : (t & 63);
                    cs = *(const f32x4*)(ropeA + pos * 16 + ((4 * i) & 15)); sn = *(const f32x4*)(ropeA + 1024 + pos * 16 + ((4 * i) & 15)); }
#pragma unroll
                for (int bj = 0; bj < 2; ++bj) {
                    const f32x4 t1 = acc[ai][bj][m][0], t2 = acc[ai][bj][m][1];
                    f32x4 o1 = t1 * cs - t2 * sn, o2 = t2 * cs + t1 * sn;
                    if (!rope) {
#pragma unroll
                        for (int jj = 0; jj < 4; ++jj) { o1[jj] = silu_f(t1[jj]); o2[jj] = silu_f(t2[jj]); }
                    }
                    u32x4 w; w.x = cvt_pk_bf16(o1[0], o1[1]); w.y = cvt_pk_bf16(o1[2], o1[3]); w.z = cvt_pk_bf16(o2[0], o2[1]); w.w = cvt_pk_bf16(o2[2], o2[3]);
                    *(u32x4*)(P + (size_t)row * PW + col0 + bj * 128) = w;
                    if (ktile) {
                        const int hh = 2 * bj + (wc >> 1), o = wr * 64 + fr + m * 16;
                        const float zf = exp2f((float)(127 - o) * (lgd[hh] * 1.4426950408889634f)), zb = exp2f((float)o * (lgd[4 + hh] * 1.4426950408889634f));
                        bf16_t* kf = KTZ + (size_t)(wc * 32 + 8 * fq + bj * 128) * MX + row; bf16_t* kb = kf + (size_t)256 * MX;
#pragma unroll
                        for (int e = 0; e < 8; ++e) { const float v = e < 4 ? o1[e & 3] : o2[e & 3]; const unsigned pk = cvt_pk_bf16(v * zf, v * zb);
                            kf[(size_t)e * MX] = (bf16_t)(pk & 0xffffu); kb[(size_t)e * MX] = (bf16_t)(pk >> 16); }
                    }
                }
            }
    }
};

template <bool ROPE> struct EpiSwapK {
    static constexpr bool PERM = true;
    bf16_t* KTZ; const float* ropeA; const float* lgd; int NT;
    __device__ __forceinline__ void operator()(const AccT& acc, const Unit& u, int wr, int wc, int fr, int fq) const {
        asm volatile("" : "+v"(fr), "+v"(fq));
        const int rbase = wr * 64 + fr;
        const int tb = u.pn * 256 + wc * 32 + 8 * fq;
        const int o0 = wc * 32 + 8 * fq;
        const int j = fr & 3; const float sgn = ((fr >> 2) & 1) ? 1.0f : -1.0f;
#pragma unroll
        for (int ai = 0; ai < 2; ++ai) {
            const int hh = 2 * ai + wr;
            const float l2f = lgd[hh] * 1.4426950408889634f, l2b = lgd[4 + hh] * 1.4426950408889634f;
            const float zf0 = exp2f((float)(127 - o0) * l2f), zfs = exp2f(-l2f), zb0 = exp2f((float)o0 * l2b), zbs = exp2f(l2b);
#pragma unroll
            for (int m = 0; m < 4; ++m) {
                const int r = rbase + ai * 128 + m * 16;
                const int d = 4 * (2 * m + (fr >> 3)) + j;
#pragma unroll
                for (int bj = 0; bj < 2; ++bj) {
                    const int t0 = tb + bj * 128;
                    float v[8];
#pragma unroll
                    for (int jj = 0; jj < 4; ++jj) { v[jj] = acc[ai][bj][m][0][jj]; v[4 + jj] = acc[ai][bj][m][1][jj]; }
                    if constexpr (ROPE) {
                        const int t = t0 & 2047;
#pragma unroll
                        for (int hf = 0; hf < 2; ++hf) {
                            f32x4 cs, sn;
                            if (m < 2) { const float c1 = ropeA[(t >> 6) * 16 + d], s1 = ropeA[1024 + (t >> 6) * 16 + d]; cs = (f32x4){c1, c1, c1, c1}; sn = (f32x4){s1, s1, s1, s1}; }
                            else { const float* cb = ropeA + 2048 + (d - 16) * 64 + (t & 63) + 4 * hf; cs = *(const f32x4*)(cb); sn = *(const f32x4*)(cb + 1024); }
#pragma unroll
                            for (int jj = 0; jj < 4; ++jj) { const float pr = __shfl_xor(v[4 * hf + jj], 4); v[4 * hf + jj] = v[4 * hf + jj] * cs[jj] + sgn * pr * sn[jj]; }
                            __builtin_amdgcn_sched_barrier(0);
                        }
                    }
                    float zf[8], zb[8]; zf[0] = zf0; zb[0] = zb0;
#pragma unroll
                    for (int jj = 1; jj < 8; ++jj) { zf[jj] = zf[jj - 1] * zfs; zb[jj] = zb[jj - 1] * zbs; }
                    u32x4 wf, wb;
                    wf.x = cvt_pk_bf16(v[0] * zf[0], v[1] * zf[1]); wf.y = cvt_pk_bf16(v[2] * zf[2], v[3] * zf[3]); wf.z = cvt_pk_bf16(v[4] * zf[4], v[5] * zf[5]); wf.w = cvt_pk_bf16(v[6] * zf[6], v[7] * zf[7]);
                    wb.x = cvt_pk_bf16(v[0] * zb[0], v[1] * zb[1]); wb.y = cvt_pk_bf16(v[2] * zb[2], v[3] * zb[3]); wb.z = cvt_pk_bf16(v[4] * zb[4], v[5] * zb[5]); wb.w = cvt_pk_bf16(v[6] * zb[6], v[7] * zb[7]);
                    *(u32x4*)(KTZ + (size_t)r * NT + t0) = wf;
                    *(u32x4*)(KTZ + (size_t)(256 + r) * NT + t0) = wb;
                    __builtin_amdgcn_sched_barrier(0);
                }
            }
        }
    }
};
struct EpiSwapVF {
    static constexpr bool PERM = true;
    bf16_t* VT; int NT;
    __device__ __forceinline__ void operator()(const AccT& acc, const Unit& u, int wr, int wc, int fr, int fq) const {
        asm volatile("" : "+v"(fr), "+v"(fq));
        const int rbase = u.pm * 256 + wr * 64 + fr;
        const int tb = u.pn * 256 + wc * 32 + 8 * fq;
#pragma unroll
        for (int ai = 0; ai < 2; ++ai)
#pragma unroll
            for (int m = 0; m < 4; ++m) {
                const int r = rbase + ai * 128 + m * 16;
#pragma unroll
                for (int bj = 0; bj < 2; ++bj) {
                    const int t0 = tb + bj * 128;
                    const f32x4 v0 = acc[ai][bj][m][0], v1 = acc[ai][bj][m][1];
                    u32x4 w; w.x = cvt_pk_bf16(v0[0], v0[1]); w.y = cvt_pk_bf16(v0[2], v0[3]); w.z = cvt_pk_bf16(v1[0], v1[1]); w.w = cvt_pk_bf16(v1[2], v1[3]);
                    *(u32x4*)(VT + (size_t)r * NT + t0) = w;
                }
            }
    }
};
struct EpiSwapF {
    static constexpr bool PERM = true;
    bf16_t* YT; int part;
    __device__ __forceinline__ void operator()(const AccT& acc, const Unit& u, int wr, int wc, int fr, int fq) const {
        asm volatile("" : "+v"(fr), "+v"(fq));
        const int rbase = u.pm * 256 + wr * 64 + fr;
        const int tb = u.pn * 256 + wc * 32 + 8 * fq;
#pragma unroll
        for (int ai = 0; ai < 2; ++ai)
#pragma unroll
            for (int m = 0; m < 4; ++m) {
                const int gm = rbase + ai * 128 + m * 16;
#pragma unroll
                for (int bj = 0; bj < 2; ++bj) {
                    const int t0 = tb + bj * 128;
                    const f32x4 v0 = acc[ai][bj][m][0], v1 = acc[ai][bj][m][1];
                    u32x4 w; w.x = cvt_pk_bf16(v0[0], v0[1]); w.y = cvt_pk_bf16(v0[2], v0[3]); w.z = cvt_pk_bf16(v1[0], v1[1]); w.w = cvt_pk_bf16(v1[2], v1[3]);
                    *(u32x4*)(YT + ((size_t)((t0 >> 10) * 512 + gm)) * 2048 + part * 1024 + (t0 & 1023)) = w;
                }
            }
    }
};

struct EpiFour {
    static constexpr bool PERM = true;
    bf16_t* CAT; const float* YCH;
    __device__ __forceinline__ void operator()(const AccT& acc, const Unit& u, int wr, int wc, int fr, int fq) const {
        asm volatile("" : "+v"(fr), "+v"(fq));
        const int row0 = u.pm * 256 + wr * 64 + fr; const int b = u.pn >> 1, ch0 = (u.pn & 1) * 256 + wc * 32 + 8 * fq;
        const float sg = (fr & 1) ? -1.0f : 1.0f;
        f32x4 yh[2][2];
#pragma unroll
        for (int bj = 0; bj < 2; ++bj)
#pragma unroll
            for (int n = 0; n < 2; ++n) yh[bj][n] = *(const f32x4*)(YCH + b * 512 + ch0 + bj * 128 + 4 * n) * sg;
#pragma unroll
        for (int ai = 0; ai < 2; ++ai)
#pragma unroll
            for (int m = 0; m < 4; ++m) {
                const int k = row0 + ai * 128 + m * 16;
#pragma unroll
                for (int bj = 0; bj < 2; ++bj) {
                    const f32x4 v0 = acc[ai][bj][m][0] + yh[bj][0], v1 = acc[ai][bj][m][1] + yh[bj][1];
                    u32x4 w; w.x = cvt_pk_bf16(v0[0], v0[1]); w.y = cvt_pk_bf16(v0[2], v0[3]); w.z = cvt_pk_bf16(v1[0], v1[1]); w.w = cvt_pk_bf16(v1[2], v1[3]);
                    *(u32x4*)(CAT + (size_t)(b * 2048 + k) * CATW + 1024 + ch0 + bj * 128) = w;
                }
            }
    }
};

template <class Epi>
__device__ __forceinline__ void run_gemm(LAS unsigned char* lds, const bf16_t* A, const bf16_t* Bt, int M, int N, int K, const Epi& E, int rot = 0, int rev = 0) {
    pg8::Gemm g; g.A = A; g.Bt = Bt; g.M = M; g.N = N; g.K = K;
    pg8::StaticOrder S; S.init(M, N, (int)gridDim.x, (int)((blockIdx.x + rot) % gridDim.x), rev);
    pg8::gemm_phase<Epi, pg8::StaticOrder>(lds, g, S, E);
}

__device__ __forceinline__ void prep_tile(unsigned char* shm, const float* src, int sld, int srow0, int scol0, bf16_t* dst, int dld, int r0, int k0, bool perm, float scale) {
    float* tile = (float*)shm;
    const int t = threadIdx.x, tx = t & 127, ty = t >> 7;
    __syncthreads();
    float ld[16];
#pragma unroll
    for (int q = 0; q < 16; ++q) ld[q] = src[(size_t)(srow0 + ty + 4 * q) * sld + scol0 + tx];
#pragma unroll
    for (int q = 0; q < 16; ++q) tile[(ty + 4 * q) * 129 + tx] = ld[q];
    __syncthreads();
    const int rr = t >> 2, ks = (t & 3) * 16;
    const int r6 = rr & 63;
    const int sc = perm ? ((rr & 64) + 32 * ((r6 >> 2) & 1) + 4 * (r6 >> 3) + (r6 & 3)) : rr;
#pragma unroll
    for (int hq = 0; hq < 2; ++hq) {
        float v[8];
#pragma unroll
        for (int q = 0; q < 8; ++q) v[q] = tile[(ks + hq * 8 + q) * 129 + sc] * scale;
        u32x4 w; w.x = cvt_pk_bf16(v[0], v[1]); w.y = cvt_pk_bf16(v[2], v[3]); w.z = cvt_pk_bf16(v[4], v[5]); w.w = cvt_pk_bf16(v[6], v[7]);
        *(u32x4*)(dst + (size_t)(r0 + rr) * dld + k0 + ks + hq * 8) = w;
    }
}

__device__ __forceinline__ void phase_prep(unsigned char* shm, const Params& p, int set, int first, int stride) {
    constexpr int J0 = 704, J1 = J0 + 352, J2 = J1 + 704, J3 = J2 + 352, J4 = J3 + 192, J5 = J4 + 96, J6 = J5 + 192, J7 = J6 + 256, J8 = J7 + 256, J9 = J8 + 144, J10 = J9 + 1;
    unsigned char* ws = p.ws;
    const int tid = threadIdx.x;
    constexpr int V0 = J1 + (J10 - J8), V1 = J8 - J1;
    for (int v = first; v < (set ? V1 : V0); v += stride) {
        const int job = set ? v + J1 : (v < J1 ? v : v - J1 + J8);
        if (job < J0 || (job >= J1 && job < J2)) {
            const bool second = job >= J1; const int jj = second ? job - J1 : job; const int rg = jj >> 4, kb = jj & 15;
            const int pn = rg >> 1, bj = rg & 1;
            prep_tile(shm, second ? p.w13_2 : p.w13_1, 5632, 64 * kb, bj * DFF + 128 * pn, (bf16_t*)(ws + (second ? OFF_WB13_2 : OFF_WB13_1)), 1024, 128 * rg, 64 * kb, false, 1.f);
        } else if (job < J1 || (job >= J2 && job < J3)) {
            const bool second = job >= J2; const int jj = second ? job - J2 : job - J0; const int rg = jj / 44, kb = jj % 44;
            prep_tile(shm, second ? p.w2_2 : p.w2_1, 1024, 64 * kb, 128 * rg, (bf16_t*)(ws + (second ? OFF_WB2_2 : OFF_WB2_1)), DFF, 128 * rg, 64 * kb, false, 1.f);
        } else if (job < J4) {
            const int jj = job - J3, rg = jj >> 4, kb = jj & 15;
            const int sc0 = rg < 4 ? 128 * rg : 128 * rg + 512;
            prep_tile(shm, p.w_in, 2560, 64 * kb, sc0, (bf16_t*)(ws + OFF_WBIN), 1024, 128 * rg, 64 * kb, rg < 4, (rg >= 2 && rg < 4) ? 0.125f : 1.f);
        } else if (job < J5) {
            const int jj = job - J4, rg = jj >> 4, kb = jj & 15;
            const int sc0 = rg < 2 ? 256 + 128 * rg : 512 + 128 * (rg - 2);
            prep_tile(shm, p.w_in, 2560, 64 * kb, sc0, (bf16_t*)(ws + OFF_WSW), 1024, 128 * rg, 64 * kb, rg < 2, rg < 2 ? 0.125f : 1.f);
        } else if (job < J6) {
            const int jj = job - J5, rg = jj / 24, kb = jj % 24;
            prep_tile(shm, p.w_out, 1024, kb < 8 ? 64 * kb : 64 * (kb - 8), 128 * rg, (bf16_t*)(ws + OFF_WOUT3), 1536, 128 * rg, 64 * kb, false, 1.f);
        } else if (job < J7) {
            const int jj = job - J6, g = jj >> 6, k0 = (jj & 63) * 16;
            float* wl = (float*)shm;
            float* trig = wl + 16 * 128;
            __syncthreads();
            for (int q = tid; q < 16 * 128; q += 512) wl[q] = p.w_in[(size_t)(k0 + (q >> 7)) * 2560 + 2048 + g * 128 + (q & 127)];
            if (tid < 128) trig[tid] = cospif((float)tid * (1.0f / 64.0f));
            __syncthreads();
            const int pm = tid & 255, kh = tid >> 8, part = pm >> 7, m = pm & 127;
            float a[8];
#pragma unroll
            for (int q = 0; q < 8; ++q) a[q] = 0.f;
            for (int c = 0; c < 128; ++c) {
                const int idx = (m * c) & 127;
                const float tr = part ? -trig[(idx + 96) & 127] : trig[idx];
#pragma unroll
                for (int q = 0; q < 8; ++q) a[q] += wl[(kh * 8 + q) * 128 + c] * tr;
            }
            u32x4 w; const float sc = 1.0f / 512.0f;
            w.x = cvt_pk_bf16(a[0] * sc, a[1] * sc); w.y = cvt_pk_bf16(a[2] * sc, a[3] * sc); w.z = cvt_pk_bf16(a[4] * sc, a[5] * sc); w.w = cvt_pk_bf16(a[6] * sc, a[7] * sc);
            *(u32x4*)((bf16_t*)(ws + OFF_WSW) + (size_t)(768 + part * 512 + g * 128 + m) * 1024 + k0 + kh * 8) = w;
        } else if (job < J8) {
            const int jj = job - J7; float* ct = (float*)shm;
            __syncthreads();
            for (int q = tid; q < 2048; q += 512) ct[q] = cospif((float)q * (1.0f / 1024.0f));
            __syncthreads();
            bf16_t* TT = (bf16_t*)(ws + OFF_TT);
            for (int q = tid; q < 8 * 256; q += 512) {
                const int k = jj * 8 + (q >> 8), pc = q & 255, part = pc >> 7, n0 = (pc & 127) * 8;
                float v[8];
#pragma unroll
                for (int e = 0; e < 8; ++e) { const int idx = (k * (n0 + e)) & 2047; v[e] = part ? ct[(idx + 1536) & 2047] : ct[idx]; }
                u32x4 w; w.x = cvt_pk_bf16(v[0], v[1]); w.y = cvt_pk_bf16(v[2], v[3]); w.z = cvt_pk_bf16(v[4], v[5]); w.w = cvt_pk_bf16(v[6], v[7]);
                *(u32x4*)(TT + (size_t)k * 2048 + part * 1024 + n0) = w;
            }
        } else if (job < J9) {
            const int jj = job - J8, col0 = jj * 64; const int wid = tid >> 6, lane = tid & 63;
            float acc[33];
#pragma unroll
            for (int b = 0; b < 33; ++b) acc[b] = 0.f;
            for (int kc = 0; kc < 2; ++kc) {
                const int kb = wid * 128 + kc * 64;
                float cv[33];
#pragma unroll
                for (int b = 0; b < 33; ++b) { const float cc = (b < 32) ? p.c[b * DM + kb + lane] : p.c_ctx[kb + lane]; cv[b] = cc / (1.0f + expf(-cc)); }
#pragma unroll 4
                for (int kk = 0; kk < 64; ++kk) {
                    const float wv = p.w_mod[(size_t)(kb + kk) * NMOD + col0 + lane];
#pragma unroll
                    for (int b = 0; b < 33; ++b) acc[b] += __uint_as_float(__builtin_amdgcn_readlane(__float_as_uint(cv[b]), kk)) * wv;
                }
            }
            float* red = (float*)shm;
            __syncthreads();
#pragma unroll
            for (int b = 0; b < 33; ++b) red[(wid * 33 + b) * 64 + lane] = acc[b];
            __syncthreads();
            float* mod = (float*)(ws + OFF_MOD);
            for (int q = tid; q < 33 * 64; q += 512) {
                const int b = q >> 6, cl = q & 63; float s = p.b_mod[col0 + cl];
#pragma unroll
                for (int w = 0; w < 8; ++w) s += red[(w * 33 + b) * 64 + cl];
                mod[(size_t)b * NMOD + col0 + cl] = s;
            }
        } else {
            float* R = (float*)(ws + OFF_ROPE);
            for (int q = tid; q < 1024; q += 512) {
                const int pos = q >> 4, f = q & 15;
                const float inv = powf(10000.0f, -(float)f / 16.0f); const float ang = (float)pos * inv;
                const float cs = cosf(ang), sn = sinf(ang);
                R[pos * 16 + f] = cs; R[1024 + pos * 16 + f] = sn; R[2048 + f * 64 + pos] = cs; R[3072 + f * 64 + pos] = sn;
            }
        }
    }
}

template <int R>
__device__ __forceinline__ void phase_norm_mod(const float* src_x, const float* src_c, int nrows, const float* g, const float* mod, int shift_off, int scale_off, bf16_t* dst, int row_begin = 0, bool local = false) {
    int tid_ = threadIdx.x; asm volatile("" : "+v"(tid_));
    const int wid = tid_ >> 6, lane = tid_ & 63;
    const int first = row_begin + (local ? wid : blockIdx.x * 8 * R + wid), step = local ? 8 * R : gridDim.x * 8 * R;
    for (int row0 = first; row0 < nrows; row0 += step) {
        const int b = row0 < MX ? (row0 >> 11) : 32;
        f32x4 v[R][4], gg[4], sc[4], sh[4];
#pragma unroll
        for (int j = 0; j < R; ++j) { const int row = row0 + 8 * j; const float* s = row < MX ? src_x + (size_t)row * DM : src_c + (size_t)(row - MX) * DM;
#pragma unroll
            for (int i = 0; i < 4; ++i) v[j][i] = (row < nrows) ? *(const f32x4*)(s + i * 256 + lane * 4) : (f32x4){0.f, 0.f, 0.f, 0.f}; }
#pragma unroll
        for (int i = 0; i < 4; ++i) { const int col = i * 256 + lane * 4; gg[i] = *(const f32x4*)(g + col); sc[i] = *(const f32x4*)(mod + (size_t)b * NMOD + scale_off + col) + 1.0f; sh[i] = *(const f32x4*)(mod + (size_t)b * NMOD + shift_off + col); }
#pragma unroll
        for (int j = 0; j < R; ++j) {
            const int row = row0 + 8 * j;
            float ss = 0.f;
#pragma unroll
            for (int i = 0; i < 4; ++i) ss += v[j][i][0] * v[j][i][0] + v[j][i][1] * v[j][i][1] + v[j][i][2] * v[j][i][2] + v[j][i][3] * v[j][i][3];
#pragma unroll
            for (int o = 32; o >= 1; o >>= 1) ss += __shfl_xor(ss, o);
            const float r = rsqrtf(ss * (1.0f / 1024.0f) + 1e-6f);
            if (row < nrows) {
#pragma unroll
                for (int i = 0; i < 4; ++i) { const f32x4 y = (v[j][i] * r) * gg[i] * sc[i] + sh[i]; u32x2 w; w.x = cvt_pk_bf16(y[0], y[1]); w.y = cvt_pk_bf16(y[2], y[3]);
                    *(u32x2*)(dst + (size_t)row * DM + i * 256 + lane * 4) = w; }
            }
        }
    }
}
template <int R>
__device__ __forceinline__ void phase_norm_mod_bf(const bf16_t* src, int nrows, const float* g, const float* mod, int shift_off, int scale_off, bf16_t* dst, int row_begin = 0) {
    int tid_ = threadIdx.x; asm volatile("" : "+v"(tid_));
    const int wid = tid_ >> 6, lane = tid_ & 63;
    for (int row0 = row_begin + blockIdx.x * 8 * R + wid; row0 < nrows; row0 += gridDim.x * 8 * R) {
        const int b = row0 < MX ? (row0 >> 11) : 32;
        u32x4 v[R][2]; f32x4 gg[2][2], sc[2][2], sh[2][2];
#pragma unroll
        for (int j = 0; j < R; ++j)
#pragma unroll
            for (int i = 0; i < 2; ++i) v[j][i] = *(const u32x4*)(src + (size_t)(row0 + 8 * j) * DM + i * 512 + lane * 8);
#pragma unroll
        for (int i = 0; i < 2; ++i)
#pragma unroll
            for (int n = 0; n < 2; ++n) { const int col = i * 512 + lane * 8 + 4 * n; gg[i][n] = *(const f32x4*)(g + col); sc[i][n] = *(const f32x4*)(mod + (size_t)b * NMOD + scale_off + col) + 1.0f; sh[i][n] = *(const f32x4*)(mod + (size_t)b * NMOD + shift_off + col); }
#pragma unroll
        for (int j = 0; j < R; ++j) {
            f32x4 x[2][2]; float ss = 0.f;
#pragma unroll
            for (int i = 0; i < 2; ++i) { x[i][0] = (f32x4){bf_lo(v[j][i].x), bf_hi(v[j][i].x), bf_lo(v[j][i].y), bf_hi(v[j][i].y)}; x[i][1] = (f32x4){bf_lo(v[j][i].z), bf_hi(v[j][i].z), bf_lo(v[j][i].w), bf_hi(v[j][i].w)};
                ss += x[i][0][0] * x[i][0][0] + x[i][0][1] * x[i][0][1] + x[i][0][2] * x[i][0][2] + x[i][0][3] * x[i][0][3] + x[i][1][0] * x[i][1][0] + x[i][1][1] * x[i][1][1] + x[i][1][2] * x[i][1][2] + x[i][1][3] * x[i][1][3]; }
#pragma unroll
            for (int o = 32; o >= 1; o >>= 1) ss += __shfl_xor(ss, o);
            const float r = rsqrtf(ss * (1.0f / 1024.0f) + 1e-6f);
#pragma unroll
            for (int i = 0; i < 2; ++i) { const f32x4 y0 = (x[i][0] * r) * gg[i][0] * sc[i][0] + sh[i][0], y1 = (x[i][1] * r) * gg[i][1] * sc[i][1] + sh[i][1];
                u32x4 w; w.x = cvt_pk_bf16(y0[0], y0[1]); w.y = cvt_pk_bf16(y0[2], y0[3]); w.z = cvt_pk_bf16(y1[0], y1[1]); w.w = cvt_pk_bf16(y1[2], y1[3]);
                *(u32x4*)(dst + (size_t)(row0 + 8 * j) * DM + i * 512 + lane * 8) = w; }
        }
    }
}

__device__ __forceinline__ void phase_norm_mix_pairs(const float* src, const float* g, const float* mod, int shift_off, int scale_off, bf16_t* dst, bf16_t* A2e, bf16_t* A2o) {
    int tid_ = threadIdx.x; asm volatile("" : "+v"(tid_));
    const int wid = tid_ >> 6, lane = tid_ & 63;
    for (int it = blockIdx.x * 8 + wid; it < 32 * 1025; it += gridDim.x * 8) {
        const int b = it / 1025, n = it - b * 1025;
        const bool pair = (n >= 1) && (n <= 1023);
        const int r1 = b * 2048 + n, r2 = pair ? b * 2048 + 2048 - n : r1;
        const float* s1 = src + (size_t)r1 * DM; const float* s2 = src + (size_t)r2 * DM;
        f32x4 v1[4], v2[4], gg[4], sc[4], sh[4]; float ss1 = 0.f, ss2 = 0.f;
#pragma unroll
        for (int i = 0; i < 4; ++i) { v1[i] = *(const f32x4*)(s1 + i * 256 + lane * 4); v2[i] = *(const f32x4*)(s2 + i * 256 + lane * 4); }
#pragma unroll
        for (int i = 0; i < 4; ++i) { const int col = i * 256 + lane * 4; gg[i] = *(const f32x4*)(g + col); sc[i] = *(const f32x4*)(mod + (size_t)b * NMOD + scale_off + col); sh[i] = *(const f32x4*)(mod + (size_t)b * NMOD + shift_off + col); }
#pragma unroll
        for (int i = 0; i < 4; ++i) { ss1 += v1[i][0] * v1[i][0] + v1[i][1] * v1[i][1] + v1[i][2] * v1[i][2] + v1[i][3] * v1[i][3]; ss2 += v2[i][0] * v2[i][0] + v2[i][1] * v2[i][1] + v2[i][2] * v2[i][2] + v2[i][3] * v2[i][3]; }
#pragma unroll
        for (int o = 32; o >= 1; o >>= 1) { ss1 += __shfl_xor(ss1, o); ss2 += __shfl_xor(ss2, o); }
        const float ra = rsqrtf(ss1 * (1.0f / 1024.0f) + 1e-6f), rb = rsqrtf(ss2 * (1.0f / 1024.0f) + 1e-6f);
        u32x2 w1[4], w2[4], we[4], wo[4];
#pragma unroll
        for (int i = 0; i < 4; ++i) {
            const f32x4 y1 = (v1[i] * ra) * gg[i] * (sc[i] + 1.0f) + sh[i], y2 = (v2[i] * rb) * gg[i] * (sc[i] + 1.0f) + sh[i];
            const f32x4 ye = pair ? (y1 + y2) : y1, yo = pair ? (y1 - y2) : (f32x4){0.f, 0.f, 0.f, 0.f};
            w1[i].x = cvt_pk_bf16(y1[0], y1[1]); w1[i].y = cvt_pk_bf16(y1[2], y1[3]); w2[i].x = cvt_pk_bf16(y2[0], y2[1]); w2[i].y = cvt_pk_bf16(y2[2], y2[3]);
            we[i].x = cvt_pk_bf16(ye[0], ye[1]); we[i].y = cvt_pk_bf16(ye[2], ye[3]); wo[i].x = cvt_pk_bf16(yo[0], yo[1]); wo[i].y = cvt_pk_bf16(yo[2], yo[3]);
        }
#pragma unroll
        for (int i = 0; i < 4; ++i) {
            const int col = i * 256 + lane * 4;
            *(u32x2*)(dst + (size_t)r1 * DM + col) = w1[i];
            if (pair) *(u32x2*)(dst + (size_t)r2 * DM + col) = w2[i];
            if (n < 1024) { *(u32x2*)(A2e + ((size_t)b * 1024 + n) * DM + col) = we[i]; *(u32x2*)(A2o + ((size_t)b * 1024 + n) * DM + col) = wo[i]; }
        }
    }
}
__device__ __forceinline__ void phase_norm_mix_pairs_bf(const bf16_t* src, const float* g, const float* mod, int shift_off, int scale_off, bf16_t* dst, bf16_t* A2e, bf16_t* A2o) {
    int tid_ = threadIdx.x; asm volatile("" : "+v"(tid_));
    const int wid = tid_ >> 6, lane = tid_ & 63;
    constexpr int PP = 6, NG = (1025 + PP - 1) / PP;
    for (int gi = blockIdx.x * 8 + wid; gi < 32 * NG; gi += gridDim.x * 8) {
        const int b = gi / NG, n0 = (gi - b * NG) * PP;
        u32x4 v1[PP][2], v2[PP][2]; f32x4 gg[2][2], sc[2][2], sh[2][2];
#pragma unroll
        for (int q = 0; q < PP; ++q) {
            const int n = n0 + q < 1025 ? n0 + q : 1024;
            const bool pair = (n >= 1) && (n <= 1023);
            const int r1 = b * 2048 + n, r2 = pair ? b * 2048 + 2048 - n : r1;
#pragma unroll
            for (int i = 0; i < 2; ++i) { v1[q][i] = *(const u32x4*)(src + (size_t)r1 * DM + i * 512 + lane * 8); v2[q][i] = *(const u32x4*)(src + (size_t)r2 * DM + i * 512 + lane * 8); }
        }
#pragma unroll
        for (int i = 0; i < 2; ++i)
#pragma unroll
            for (int n = 0; n < 2; ++n) { const int col = i * 512 + lane * 8 + 4 * n; gg[i][n] = *(const f32x4*)(g + col); sc[i][n] = *(const f32x4*)(mod + (size_t)b * NMOD + scale_off + col) + 1.0f; sh[i][n] = *(const f32x4*)(mod + (size_t)b * NMOD + shift_off + col); }
#pragma unroll
        for (int q = 0; q < PP; ++q) {
            const int n = n0 + q;
            const bool valid = n < 1025, pair = (n >= 1) && (n <= 1023);
            const int r1 = b * 2048 + n, r2 = b * 2048 + 2048 - n;
            f32x4 x1[2][2], x2[2][2]; float ss1 = 0.f, ss2 = 0.f;
#pragma unroll
            for (int i = 0; i < 2; ++i) {
                x1[i][0] = (f32x4){bf_lo(v1[q][i].x), bf_hi(v1[q][i].x), bf_lo(v1[q][i].y), bf_hi(v1[q][i].y)}; x1[i][1] = (f32x4){bf_lo(v1[q][i].z), bf_hi(v1[q][i].z), bf_lo(v1[q][i].w), bf_hi(v1[q][i].w)};
                x2[i][0] = (f32x4){bf_lo(v2[q][i].x), bf_hi(v2[q][i].x), bf_lo(v2[q][i].y), bf_hi(v2[q][i].y)}; x2[i][1] = (f32x4){bf_lo(v2[q][i].z), bf_hi(v2[q][i].z), bf_lo(v2[q][i].w), bf_hi(v2[q][i].w)};
#pragma unroll
                for (int n2 = 0; n2 < 2; ++n2) { ss1 += x1[i][n2][0] * x1[i][n2][0] + x1[i][n2][1] * x1[i][n2][1] + x1[i][n2][2] * x1[i][n2][2] + x1[i][n2][3] * x1[i][n2][3];
                                                  ss2 += x2[i][n2][0] * x2[i][n2][0] + x2[i][n2][1] * x2[i][n2][1] + x2[i][n2][2] * x2[i][n2][2] + x2[i][n2][3] * x2[i][n2][3]; }
            }
#pragma unroll
            for (int o = 32; o >= 1; o >>= 1) { ss1 += __shfl_xor(ss1, o); ss2 += __shfl_xor(ss2, o); }
            const float ra = rsqrtf(ss1 * (1.0f / 1024.0f) + 1e-6f), rb = rsqrtf(ss2 * (1.0f / 1024.0f) + 1e-6f);
            if (valid) {
#pragma unroll
                for (int i = 0; i < 2; ++i) {
                    const int col = i * 512 + lane * 8;
                    f32x4 y1[2], y2[2], ye[2], yo[2];
#pragma unroll
                    for (int n2 = 0; n2 < 2; ++n2) { y1[n2] = (x1[i][n2] * ra) * gg[i][n2] * sc[i][n2] + sh[i][n2]; y2[n2] = (x2[i][n2] * rb) * gg[i][n2] * sc[i][n2] + sh[i][n2];
                        ye[n2] = pair ? (y1[n2] + y2[n2]) : y1[n2]; yo[n2] = pair ? (y1[n2] - y2[n2]) : (f32x4){0.f, 0.f, 0.f, 0.f}; }
                    u32x4 w1, w2, we, wo;
                    w1.x = cvt_pk_bf16(y1[0][0], y1[0][1]); w1.y = cvt_pk_bf16(y1[0][2], y1[0][3]); w1.z = cvt_pk_bf16(y1[1][0], y1[1][1]); w1.w = cvt_pk_bf16(y1[1][2], y1[1][3]);
                    w2.x = cvt_pk_bf16(y2[0][0], y2[0][1]); w2.y = cvt_pk_bf16(y2[0][2], y2[0][3]); w2.z = cvt_pk_bf16(y2[1][0], y2[1][1]); w2.w = cvt_pk_bf16(y2[1][2], y2[1][3]);
                    we.x = cvt_pk_bf16(ye[0][0], ye[0][1]); we.y = cvt_pk_bf16(ye[0][2], ye[0][3]); we.z = cvt_pk_bf16(ye[1][0], ye[1][1]); we.w = cvt_pk_bf16(ye[1][2], ye[1][3]);
                    wo.x = cvt_pk_bf16(yo[0][0], yo[0][1]); wo.y = cvt_pk_bf16(yo[0][2], yo[0][3]); wo.z = cvt_pk_bf16(yo[1][0], yo[1][1]); wo.w = cvt_pk_bf16(yo[1][2], yo[1][3]);
                    *(u32x4*)(dst + (size_t)r1 * DM + col) = w1;
                    if (pair) *(u32x4*)(dst + (size_t)r2 * DM + col) = w2;
                    if (n < 1024) { *(u32x4*)(A2e + ((size_t)b * 1024 + n) * DM + col) = we; *(u32x4*)(A2o + ((size_t)b * 1024 + n) * DM + col) = wo; }
                }
            }
        }
    }
}

__device__ __forceinline__ void phase_ych(const bf16_t* A2, const bf16_t* Wc, float* YCH) {
    int tid_ = threadIdx.x; asm volatile("" : "+v"(tid_));
    const int wid = tid_ >> 6, lane = tid_ & 63;
    for (int o = blockIdx.x * 8 + wid; o < 32 * 512; o += gridDim.x * 8) {
        const int b = o >> 9, gm = o & 511;
        const bf16_t* a = A2 + ((size_t)b * 2048 + 1024) * DM + lane * 16; const bf16_t* w = Wc + (size_t)gm * DM + lane * 16;
        float acc = 0.f;
#pragma unroll
        for (int q = 0; q < 2; ++q) { const u32x4 av = *(const u32x4*)(a + q * 8), wv = *(const u32x4*)(w + q * 8);
            acc += bf_lo(av.x) * bf_lo(wv.x) + bf_hi(av.x) * bf_hi(wv.x) + bf_lo(av.y) * bf_lo(wv.y) + bf_hi(av.y) * bf_hi(wv.y) + bf_lo(av.z) * bf_lo(wv.z) + bf_hi(av.z) * bf_hi(wv.z) + bf_lo(av.w) * bf_lo(wv.w) + bf_hi(av.w) * bf_hi(wv.w); }
#pragma unroll
        for (int sft = 32; sft >= 1; sft >>= 1) acc += __shfl_xor(acc, sft);
        if (lane == 0) YCH[o] = acc;
    }
}
__device__ __forceinline__ void phase_final_norm(const bf16_t* hb, float* out, const float* g) {
    int tid_ = threadIdx.x; asm volatile("" : "+v"(tid_));
    const int wid = tid_ >> 6, lane = tid_ & 63;
    constexpr int R = 8;
    f32x4 gg[2][2];
#pragma unroll
    for (int i = 0; i < 2; ++i) { gg[i][0] = *(const f32x4*)(g + i * 512 + lane * 8); gg[i][1] = *(const f32x4*)(g + i * 512 + lane * 8 + 4); }
    for (int row0 = blockIdx.x * 8 * R + wid; row0 < MX; row0 += gridDim.x * 8 * R) {
        u32x4 v[R][2];
#pragma unroll
        for (int j = 0; j < R; ++j)
#pragma unroll
            for (int i = 0; i < 2; ++i) v[j][i] = *(const u32x4*)(hb + (size_t)(row0 + 8 * j) * DM + i * 512 + lane * 8);
#pragma unroll
        for (int j = 0; j < R; ++j) {
            f32x4 x[2][2]; float ss = 0.f;
#pragma unroll
            for (int i = 0; i < 2; ++i) { x[i][0] = (f32x4){bf_lo(v[j][i].x), bf_hi(v[j][i].x), bf_lo(v[j][i].y), bf_hi(v[j][i].y)}; x[i][1] = (f32x4){bf_lo(v[j][i].z), bf_hi(v[j][i].z), bf_lo(v[j][i].w), bf_hi(v[j][i].w)};
                ss += x[i][0][0] * x[i][0][0] + x[i][0][1] * x[i][0][1] + x[i][0][2] * x[i][0][2] + x[i][0][3] * x[i][0][3] + x[i][1][0] * x[i][1][0] + x[i][1][1] * x[i][1][1] + x[i][1][2] * x[i][1][2] + x[i][1][3] * x[i][1][3]; }
#pragma unroll
            for (int o = 32; o >= 1; o >>= 1) ss += __shfl_xor(ss, o);
            const float r = rsqrtf(ss * (1.0f / 1024.0f) + 1e-6f);
#pragma unroll
            for (int i = 0; i < 2; ++i) { float* o = out + (size_t)(row0 + 8 * j) * DM + i * 512 + lane * 8; *(f32x4*)(o) = (x[i][0] * r) * gg[i][0]; *(f32x4*)(o + 4) = (x[i][1] * r) * gg[i][1]; }
        }
    }
}

struct RetStep { size_t tok0; size_t NT; const bf16_t* vt; const bf16_t* kz; bool isctx; };
__device__ __forceinline__ RetStep ret_step(const Params& p, int step, int b, int dir) {
    RetStep r;
    r.isctx = step < 2;
    if (r.isctx) { const int ci = dir ? 1 - step : step; r.tok0 = (size_t)b * 256 + ci * 128; r.NT = MC; r.vt = (const bf16_t*)(p.ws + OFF_VTC); r.kz = (const bf16_t*)(p.ws + OFF_KTZC); }
    else { const int s = step - 2; const int ci = dir ? 15 - s : s; r.tok0 = (size_t)b * 2048 + ci * 128; r.NT = MX; r.vt = (const bf16_t*)(p.ws + OFF_VT); r.kz = (const bf16_t*)(p.ws + OFF_KTZ); }
    return r;
}
__device__ __forceinline__ void retention_item(LAS unsigned char* lds, const Params& p, int item) {
    int tid_ = threadIdx.x; asm volatile("" : "+v"(tid_));
    const int tid = tid_, wid = __builtin_amdgcn_readfirstlane(tid >> 6), lane = tid & 63, fr = lane & 15, fq = lane >> 4;
    const int b = item >> 3, h = (item >> 1) & 3, dir = item & 1;
    const float l2g = p.ret_log_decay[dir * 4 + h] * 1.4426950408889634f;
    const float decayC = exp2f(128.0f * l2g);
    LAS bf16_t* Ks = (LAS bf16_t*)lds;
    LAS bf16_t* Vts = Ks + 128 * 80;
    LAS bf16_t* Kzs = Vts + 128 * 136;
    LAS bf16_t* Sts = Kzs + 64 * 136;
    const bf16_t* P = (const bf16_t*)(p.ws + OFF_P);
    bf16_t* CAT = (bf16_t*)(p.ws + OFF_A);
    const int c = 16 * wid + fr;
    const float xi = exp2f((float)(dir ? (128 - c) : (c + 1)) * l2g);
    f32x4 accSt[4];
#pragma unroll
    for (int db = 0; db < 4; ++db) accSt[db] = (f32x4){0.f, 0.f, 0.f, 0.f};
    u32x4 pk[2], pv[4], pz[2]; bf16x8 pq[2]; u32x2 pg[8];
#pragma unroll
    for (int q = 0; q < 2; ++q) { pk[q] = (u32x4){0u, 0u, 0u, 0u}; pq[q] = __builtin_bit_cast(bf16x8, pk[q]); }
#pragma unroll
    for (int q = 0; q < 8; ++q) pg[q] = (u32x2){0u, 0u};
    {   const RetStep r = ret_step(p, 0, b, dir);
#pragma unroll
        for (int q = 0; q < 4; ++q) { const int pc = tid + q * 512, row = pc >> 4, seg = pc & 15; pv[q] = *(const u32x4*)(r.vt + (size_t)(128 * h + row) * r.NT + r.tok0 + seg * 8); }
#pragma unroll
        for (int q = 0; q < 2; ++q) { const int pc = tid + q * 512, row = pc >> 4, seg = pc & 15; pz[q] = *(const u32x4*)(r.kz + (size_t)(dir * 256 + 64 * h + row) * r.NT + r.tok0 + seg * 8); }
    }
    for (int step = 0; step < 18; ++step) {
        const RetStep cur = ret_step(p, step, b, dir);
        if (!cur.isctx) {
#pragma unroll
            for (int q = 0; q < 2; ++q) { const int pc = tid + q * 512, row = pc >> 3, seg = pc & 7; *(LAS u32x4*)(Ks + row * 80 + seg * 8) = pk[q]; }
        }
#pragma unroll
        for (int q = 0; q < 4; ++q) { const int pc = tid + q * 512, row = pc >> 4, seg = pc & 15; *(LAS u32x4*)(Vts + row * 136 + seg * 8) = pv[q]; }
#pragma unroll
        for (int q = 0; q < 2; ++q) { const int pc = tid + q * 512, row = pc >> 4, seg = pc & 15; *(LAS u32x4*)(Kzs + row * 136 + seg * 8) = pz[q]; }
        bf16x8 bq[2]; bq[0] = pq[0]; bq[1] = pq[1];
        if (step + 1 < 18) {
            const RetStep nx = ret_step(p, step + 1, b, dir);
            if (!nx.isctx) {
#pragma unroll
                for (int q = 0; q < 2; ++q) { const int pc = tid + q * 512, row = pc >> 3, seg = pc & 7; pk[q] = *(const u32x4*)(P + (nx.tok0 + row) * PW + 256 + 64 * h + seg * 8); }
                const bf16_t* qrow = P + (nx.tok0 + c) * PW + 64 * h + 8 * fq;
                pq[0] = *(const bf16x8*)(qrow); pq[1] = *(const bf16x8*)(qrow + 32);
            }
#pragma unroll
            for (int q = 0; q < 4; ++q) { const int pc = tid + q * 512, row = pc >> 4, seg = pc & 15; pv[q] = *(const u32x4*)(nx.vt + (size_t)(128 * h + row) * nx.NT + nx.tok0 + seg * 8); }
#pragma unroll
            for (int q = 0; q < 2; ++q) { const int pc = tid + q * 512, row = pc >> 4, seg = pc & 15; pz[q] = *(const u32x4*)(nx.kz + (size_t)(dir * 256 + 64 * h + row) * nx.NT + nx.tok0 + seg * 8); }
            if (step == 1) {
                const bf16_t* grow = P + (nx.tok0 + c) * PW + 512 + dir * 512 + 128 * h + 4 * fq;
#pragma unroll
                for (int eb = 0; eb < 8; ++eb) pg[eb] = *(const u32x2*)(grow + 16 * eb);
            }
        }
        __syncthreads();
        if (!cur.isctx) {
            bf16x8 qx[2];
#pragma unroll
            for (int s = 0; s < 2; ++s) { const u32x4 raw = __builtin_bit_cast(u32x4, bq[s]); u32x4 o;
                o.x = cvt_pk_bf16(bf_lo(raw.x) * xi, bf_hi(raw.x) * xi); o.y = cvt_pk_bf16(bf_lo(raw.y) * xi, bf_hi(raw.y) * xi);
                o.z = cvt_pk_bf16(bf_lo(raw.z) * xi, bf_hi(raw.z) * xi); o.w = cvt_pk_bf16(bf_lo(raw.w) * xi, bf_hi(raw.w) * xi);
                qx[s] = __builtin_bit_cast(bf16x8, o); }
            bf16x8 pf[4];
#pragma unroll
            for (int ks = 0; ks < 4; ++ks) {
                const bool live = dir ? (2 * ks + 1 >= wid) : (2 * ks <= wid);
                u32x4 o = {0u, 0u, 0u, 0u};
                if (live) {
                    f32x4 sc[2];
                    bf16x8 ka[2][2];
#pragma unroll
                    for (int q = 0; q < 2; ++q)
#pragma unroll
                        for (int s = 0; s < 2; ++s) ka[q][s] = *(const LAS bf16x8*)(Ks + (16 * (2 * ks + q) + fr) * 80 + 32 * s + 8 * fq);
                    __builtin_amdgcn_sched_barrier(0);
                    __builtin_amdgcn_s_setprio(1);
#pragma unroll
                    for (int q = 0; q < 2; ++q) { sc[q] = (f32x4){0.f, 0.f, 0.f, 0.f};
#pragma unroll
                        for (int s = 0; s < 2; ++s) sc[q] = __builtin_amdgcn_mfma_f32_16x16x32_bf16(ka[q][s], bq[s], sc[q], 0, 0, 0); }
                    __builtin_amdgcn_s_setprio(0);
#pragma unroll
                    for (int q = 0; q < 2; ++q) { const int mb = 2 * ks + q;
#pragma unroll
                        for (int r = 0; r < 4; ++r) { const int m = 16 * mb + 4 * fq + r; const int diff = dir ? (m - c) : (c - m); sc[q][r] = diff >= 0 ? sc[q][r] * __builtin_amdgcn_exp2f((float)diff * l2g) : 0.f; }
                    }
                    o.x = cvt_pk_bf16(sc[0][0], sc[0][1]); o.y = cvt_pk_bf16(sc[0][2], sc[0][3]); o.z = cvt_pk_bf16(sc[1][0], sc[1][1]); o.w = cvt_pk_bf16(sc[1][2], sc[1][3]);
                }
                pf[ks] = __builtin_bit_cast(bf16x8, o);
            }
            f32x4 accO[8];
#pragma unroll
            for (int eb = 0; eb < 8; ++eb) accO[eb] = (f32x4){0.f, 0.f, 0.f, 0.f};
#pragma unroll
            for (int s = 0; s < 2; ++s) {
                bf16x8 sa[8];
#pragma unroll
                for (int eb = 0; eb < 8; ++eb) sa[eb] = *(const LAS bf16x8*)(Sts + (16 * eb + fr) * 80 + 32 * s + 8 * fq);
                __builtin_amdgcn_sched_barrier(0);
                __builtin_amdgcn_s_setprio(1);
#pragma unroll
                for (int eb = 0; eb < 8; ++eb) accO[eb] = __builtin_amdgcn_mfma_f32_16x16x32_bf16(sa[eb], qx[s], accO[eb], 0, 0, 0);
                __builtin_amdgcn_s_setprio(0);
                __builtin_amdgcn_sched_barrier(0);
            }
#pragma unroll
            for (int ks = 0; ks < 4; ++ks) {
                const bool live = dir ? (2 * ks + 1 >= wid) : (2 * ks <= wid);
                if (live) {
                    u32x4 va[8];
#pragma unroll
                    for (int eb = 0; eb < 8; ++eb) {
                        const u32x2 lo = *(const LAS u32x2*)(Vts + (16 * eb + fr) * 136 + 32 * ks + 4 * fq), hi = *(const LAS u32x2*)(Vts + (16 * eb + fr) * 136 + 32 * ks + 16 + 4 * fq);
                        va[eb] = (u32x4){lo.x, lo.y, hi.x, hi.y};
                    }
                    __builtin_amdgcn_sched_barrier(0);
                    __builtin_amdgcn_s_setprio(1);
#pragma unroll
                    for (int eb = 0; eb < 8; ++eb) accO[eb] = __builtin_amdgcn_mfma_f32_16x16x32_bf16(__builtin_bit_cast(bf16x8, va[eb]), pf[ks], accO[eb], 0, 0, 0);
                    __builtin_amdgcn_s_setprio(0);
                    __builtin_amdgcn_sched_barrier(0);
                }
            }
            float sm = 0.f;
#pragma unroll
            for (int eb = 0; eb < 8; ++eb) sm += (accO[eb][0] + accO[eb][1]) + (accO[eb][2] + accO[eb][3]);
            sm += __shfl_xor(sm, 16); sm += __shfl_xor(sm, 32);
            const float mean = sm * (1.0f / 128.0f);
            float vq = 0.f;
#pragma unroll
            for (int eb = 0; eb < 8; ++eb) { const f32x4 d = accO[eb] - mean; vq += (d[0] * d[0] + d[1] * d[1]) + (d[2] * d[2] + d[3] * d[3]); }
            vq += __shfl_xor(vq, 16); vq += __shfl_xor(vq, 32);
            const float rstd = rsqrtf(vq * (1.0f / 128.0f) + 1e-6f);
            bf16_t* yrow = CAT + (cur.tok0 + c) * CATW + dir * 512 + 128 * h + 4 * fq;
#pragma unroll
            for (int eb = 0; eb < 8; ++eb) {
                const u32x2 gr = pg[eb];
                const f32x4 y = (accO[eb] - mean) * rstd;
                u32x2 w; w.x = cvt_pk_bf16(bf_lo(gr.x) * y[0], bf_hi(gr.x) * y[1]); w.y = cvt_pk_bf16(bf_lo(gr.y) * y[2], bf_hi(gr.y) * y[3]);
                *(u32x2*)(yrow + 16 * eb) = w;
            }
            if (step + 1 < 18) {
                const RetStep nx = ret_step(p, step + 1, b, dir);
                const bf16_t* grow = P + (nx.tok0 + c) * PW + 512 + dir * 512 + 128 * h + 4 * fq;
#pragma unroll
                for (int eb = 0; eb < 8; ++eb) pg[eb] = *(const u32x2*)(grow + 16 * eb);
            }
        }
#pragma unroll
        for (int db = 0; db < 4; ++db) accSt[db] = accSt[db] * decayC;
#pragma unroll
        for (int kh = 0; kh < 2; ++kh) {
            bf16x8 a[2], bb[2][4];
#pragma unroll
            for (int q = 0; q < 2; ++q) { const int ks = 2 * kh + q; a[q] = *(const LAS bf16x8*)(Vts + (16 * wid + fr) * 136 + 32 * ks + 8 * fq);
#pragma unroll
                for (int db = 0; db < 4; ++db) bb[q][db] = *(const LAS bf16x8*)(Kzs + (16 * db + fr) * 136 + 32 * ks + 8 * fq); }
            __builtin_amdgcn_sched_barrier(0);
            __builtin_amdgcn_s_setprio(1);
#pragma unroll
            for (int q = 0; q < 2; ++q)
#pragma unroll
                for (int db = 0; db < 4; ++db) accSt[db] = __builtin_amdgcn_mfma_f32_16x16x32_bf16(a[q], bb[q][db], accSt[db], 0, 0, 0);
            __builtin_amdgcn_s_setprio(0);
            __builtin_amdgcn_sched_barrier(0);
        }
        __syncthreads();
#pragma unroll
        for (int db = 0; db < 4; ++db)
#pragma unroll
            for (int r = 0; r < 4; ++r) Sts[(16 * wid + 4 * fq + r) * 80 + 16 * db + fr] = (bf16_t)(cvt_pk_bf16(accSt[db][r], 0.f) & 0xffffu);
    }
    __syncthreads();
}

#define XB_TMO      128
#define XB_XCNT(j)  (256  + 64 * (j))
#define XB_XSUB(j)  (1280 + 64 * (j))
#define XB_XGEN(j)  (2304 + 64 * (j))
#define XB_TOP      3328
#define XB_TOPGEN   3392
#define XCD_BAR_WORDS 3456
#define XB_SPIN_CAP (1u << 18)
__device__ __forceinline__ unsigned xb_ld(unsigned* p)              { return __hip_atomic_load(p, __ATOMIC_RELAXED, __HIP_MEMORY_SCOPE_AGENT); }
__device__ __forceinline__ unsigned xb_add(unsigned* p, unsigned v) { return __hip_atomic_fetch_add(p, v, __ATOMIC_RELAXED, __HIP_MEMORY_SCOPE_AGENT); }
__device__ __forceinline__ unsigned xb_xcc_id() { return (unsigned)__builtin_amdgcn_s_getreg((3 << 11) | 20) & 0xFu; }
#define XB_SPIN(cond, bar) do { unsigned _sp = 0; while (cond) { __builtin_amdgcn_s_sleep(1); \
    if ((++_sp & 255u) == 0u) { if (xb_ld(&(bar)[XB_TMO])) break; if (_sp > XB_SPIN_CAP) { atomicAdd(&(bar)[XB_TMO], 1u); break; } } } } while (0)
struct XcdBarrier { unsigned* bar; unsigned x; volatile LAS unsigned* st; };
__device__ __forceinline__ XcdBarrier xcd_barrier_post(unsigned* bar, volatile LAS unsigned* st) {
    XcdBarrier b; b.bar = bar; b.x = xb_xcc_id(); b.st = st;
    if (threadIdx.x == 0) (void)xb_add(&bar[XB_XCNT(b.x)], 1u);
    return b;
}
__device__ __forceinline__ void xcd_barrier_complete(unsigned* bar, unsigned x, unsigned& nloc, unsigned& nx) {
    const unsigned G = gridDim.x * gridDim.y * gridDim.z;
    unsigned sum, cnt, mine, sp = 0u;
    for (;;) {
        sum = 0u; cnt = 0u; mine = 0u;
#pragma unroll
        for (unsigned j = 0; j < 16; ++j) { const unsigned c = xb_ld(&bar[XB_XCNT(j)]); sum += c; cnt += (c > 0u) ? 1u : 0u; mine = (j == x) ? c : mine; }
        if (sum == G) break;
        __builtin_amdgcn_s_sleep(1);
        if ((++sp & 255u) == 0u) { if (xb_ld(&bar[XB_TMO])) break; if (sp > XB_SPIN_CAP) { atomicAdd(&bar[XB_TMO], 1u); break; } }
    }
    nloc = mine > 0u ? mine : 1u; nx = cnt > 0u ? cnt : 1u;
}
__device__ __forceinline__ void xcd_barrier(const XcdBarrier& b) {
    asm volatile("s_waitcnt vmcnt(0)" ::: "memory");
    __syncthreads();
    if (threadIdx.x == 0) {
        unsigned* bar = b.bar;
        __builtin_amdgcn_s_waitcnt(0);
        unsigned nloc = b.st[0], nx = b.st[1];
        if (nloc == 0u) { xcd_barrier_complete(bar, b.x, nloc, nx); b.st[0] = nloc; b.st[1] = nx; }
        const unsigned old = xb_add(&bar[XB_XSUB(b.x)], 1u);
        const unsigned gen = old / nloc;
        if (old + 1u == (gen + 1u) * nloc) {
            __builtin_amdgcn_fence(__ATOMIC_RELEASE, "agent");
            asm volatile("s_waitcnt vmcnt(0)" ::: "memory");
            const unsigned og = xb_add(&bar[XB_TOP], 1u);
            const unsigned tg = og / nx;
            if (og + 1u == (tg + 1u) * nx) xb_add(&bar[XB_TOPGEN], 1u);
            else XB_SPIN(xb_ld(&bar[XB_TOPGEN]) == tg, bar);
            __builtin_amdgcn_fence(__ATOMIC_ACQUIRE, "agent");
            xb_add(&bar[XB_XGEN(b.x)], 1u);
            asm volatile("s_waitcnt vmcnt(0)" ::: "memory");
        } else {
            XB_SPIN(xb_ld(&bar[XB_XGEN(b.x)]) == gen, bar);
            __builtin_amdgcn_fence(__ATOMIC_ACQUIRE, "agent");
            asm volatile("s_waitcnt vmcnt(0)" ::: "memory");
        }
    }
    __syncthreads();
}

#define GRID_SYNC() do { asm volatile("s_waitcnt vmcnt(0)" ::: "memory"); __syncthreads(); cg::this_grid().sync(); } while (0)
__global__ void __launch_bounds__(512, 2) fwd_megakernel(Params p) {
    extern __shared__ __attribute__((aligned(16))) unsigned char shm[];
    LAS unsigned char* lds = (LAS unsigned char*)shm;
    unsigned char* ws = p.ws;
    const float* mod = (const float*)(ws + OFF_MOD);
    bf16_t* Abuf = (bf16_t*)(ws + OFF_A);
    bf16_t* Hbuf = (bf16_t*)(ws + OFF_H);
    float* hc = (float*)(ws + OFF_HC);

    unsigned* barw = (unsigned*)(ws + OFF_BAR);
    if (blockIdx.x == 0) for (int i = threadIdx.x; i < XCD_BAR_WORDS; i += 512) barw[i] = 0u;
    volatile LAS unsigned* bst = (volatile LAS unsigned*)(lds + 131072);
    if (threadIdx.x < 4) bst[threadIdx.x] = 0u;
    phase_prep(shm, p, 0, (int)blockIdx.x, (int)gridDim.x);
    GRID_SYNC();
    const XcdBarrier xb = xcd_barrier_post(barw, bst);
    phase_norm_mod<8>(p.x, p.ctx, MT, p.norm_ffn1, mod, 0 * DM, 1 * DM, Abuf);
    xcd_barrier(xb);
    { EpiSwiGLU e; e.H = Hbuf; run_gemm(lds, Abuf, (const bf16_t*)(ws + OFF_WB13_1), MT, 5632, 1024, e); }
    xcd_barrier(xb);
    bf16_t* h1b = (bf16_t*)p.out;
    { EpiResidBfC e; e.res_x = p.x; e.res_c = p.ctx; e.hb = h1b; e.gate = mod + 2 * DM; e.gs = 0.5f; run_gemm(lds, Hbuf, (const bf16_t*)(ws + OFF_WB2_1), MT, 1024, DFF, e, 0, 1); }
    { const int rem = (int)((MT / 256 * 4) % gridDim.x);
      if (rem == 0) phase_prep(shm, p, 1, (int)blockIdx.x, (int)gridDim.x);
      else if ((int)blockIdx.x >= rem) phase_prep(shm, p, 1, (int)blockIdx.x - rem, (int)gridDim.x - rem); }
    xcd_barrier(xb);
    phase_norm_mix_pairs_bf(h1b, p.norm_mix, mod, 3 * DM, 4 * DM, Abuf, (bf16_t*)(ws + OFF_A2E), (bf16_t*)(ws + OFF_A2O));
    phase_norm_mod_bf<4>(h1b, MT, p.norm_mix, mod, 3 * DM, 4 * DM, Abuf, MX);
    xcd_barrier(xb);
    phase_ych(Abuf, (const bf16_t*)(ws + OFF_WSW) + (size_t)768 * 1024, (float*)(ws + OFF_YCH));
    { EpiInProj e; e.P = (bf16_t*)(ws + OFF_P); e.ropeA = (const float*)(ws + OFF_ROPE); e.KTZ = (bf16_t*)(ws + OFF_KTZ); e.lgd = p.ret_log_decay; run_gemm(lds, Abuf, (const bf16_t*)(ws + OFF_WBIN), MX, 1536, 1024, e); }
    { EpiSwapVF e; e.VT = (bf16_t*)(ws + OFF_VT); e.NT = MX;
      run_gemm(lds, (const bf16_t*)(ws + OFF_WSW) + (size_t)256 * 1024, Abuf, 512, MX, 1024, e); }
    { EpiSwapF e; e.YT = (bf16_t*)(ws + OFF_YT); e.part = 0;
      run_gemm(lds, (const bf16_t*)(ws + OFF_WSW) + (size_t)768 * 1024, (const bf16_t*)(ws + OFF_A2E), 512, 32768, 1024, e); }
    { EpiSwapF e; e.YT = (bf16_t*)(ws + OFF_YT); e.part = 1;
      run_gemm(lds, (const bf16_t*)(ws + OFF_WSW) + (size_t)1280 * 1024, (const bf16_t*)(ws + OFF_A2O), 512, 32768, 1024, e); }
    { EpiSwapK<false> e; e.KTZ = (bf16_t*)(ws + OFF_KTZC); e.ropeA = (const float*)(ws + OFF_ROPE); e.lgd = p.ret_log_decay; e.NT = MC;
      run_gemm(lds, (const bf16_t*)(ws + OFF_WSW), Abuf + (size_t)MX * DM, 256, MC, 1024, e, 256 - 32); }
    { EpiSwapVF e; e.VT = (bf16_t*)(ws + OFF_VTC); e.NT = MC;
      run_gemm(lds, (const bf16_t*)(ws + OFF_WSW) + (size_t)256 * 1024, Abuf + (size_t)MX * DM, 512, MC, 1024, e, 256 - 96); }
    xcd_barrier(xb);
    for (int item = blockIdx.x; item < 256; item += gridDim.x) retention_item(lds, p, item);
    { EpiFour e; e.CAT = Abuf; e.YCH = (const float*)(ws + OFF_YCH); run_gemm(lds, (const bf16_t*)(ws + OFF_TT), (const bf16_t*)(ws + OFF_YT), 2048, 16384, 2048, e); }
    xcd_barrier(xb);
    { EpiResidBfBf e; e.res_b = h1b; e.hb = (bf16_t*)(ws + OFF_H2B); e.gate = mod + 5 * DM; e.gs = 1.0f; run_gemm(lds, Abuf, (const bf16_t*)(ws + OFF_WOUT3), MX, 1024, 1536, e); }
    xcd_barrier(xb);
    phase_norm_mod_bf<8>((const bf16_t*)(ws + OFF_H2B), MX, p.norm_ffn2, mod, 6 * DM, 7 * DM, Abuf);
    xcd_barrier(xb);
    { EpiSwiGLU e; e.H = Hbuf; run_gemm(lds, Abuf, (const bf16_t*)(ws + OFF_WB13_2), MX, 5632, 1024, e); }
    xcd_barrier(xb);
    { EpiResidBfBf e; e.res_b = (const bf16_t*)(ws + OFF_H2B); e.hb = Abuf; e.gate = mod + 8 * DM; e.gs = 0.5f; run_gemm(lds, Hbuf, (const bf16_t*)(ws + OFF_WB2_2), MX, 1024, DFF, e, 0, 1); }
    xcd_barrier(xb);
    phase_final_norm(Abuf, p.out, p.norm_final);
}

extern "C" void kernel_launch(void* const* d_in, const int* in_sizes, int n_in, void* d_out, int out_size, void* d_ws, size_t ws_size, hipStream_t stream) {
    static int grid_blocks = 0;
    if (grid_blocks == 0) {
        if (n_in != 17 || ws_size < WS_END) { fprintf(stderr, "kernel_launch: unexpected n_in %d or ws_size %zu (< %zu)\n", n_in, ws_size, (size_t)WS_END); grid_blocks = -1; return; }
        int dev = 0, cus = 0, per_cu = 0;
        hipGetDevice(&dev);
        hipDeviceGetAttribute(&cus, hipDeviceAttributeMultiprocessorCount, dev);
        hipFuncSetAttribute((const void*)fwd_megakernel, hipFuncAttributeMaxDynamicSharedMemorySize, LDS_BYTES);
        hipOccupancyMaxActiveBlocksPerMultiprocessor(&per_cu, (const void*)fwd_megakernel, 512, LDS_BYTES);
        if (per_cu < 1) per_cu = 1;
        grid_blocks = cus * per_cu;
        fprintf(stderr, "kernel_launch: cus %d per_cu %d grid %d ws %zu need %zu\n", cus, per_cu, grid_blocks, ws_size, (size_t)WS_END);
    }
    if (grid_blocks < 0) return;
    Params p{};
    p.x = (const float*)d_in[0]; p.c = (const float*)d_in[1]; p.ctx = (const float*)d_in[2]; p.c_ctx = (const float*)d_in[3];
    p.w_mod = (const float*)d_in[4]; p.b_mod = (const float*)d_in[5]; p.norm_ffn1 = (const float*)d_in[6]; p.w13_1 = (const float*)d_in[7]; p.w2_1 = (const float*)d_in[8];
    p.norm_mix = (const float*)d_in[9]; p.w_in = (const float*)d_in[10]; p.ret_log_decay = (const float*)d_in[11]; p.w_out = (const float*)d_in[12];
    p.norm_ffn2 = (const float*)d_in[13]; p.w13_2 = (const float*)d_in[14]; p.w2_2 = (const float*)d_in[15]; p.norm_final = (const float*)d_in[16];
    p.out = (float*)d_out; p.ws = (unsigned char*)d_ws;
    void* args[] = {&p};
    hipError_t e = hipLaunchCooperativeKernel((const void*)fwd_megakernel, dim3(grid_blocks), dim3(512), args, LDS_BYTES, stream);
    if (e != hipSuccess) fprintf(stderr, "cooperative launch failed: %s (grid %d)\n", hipGetErrorString(e), grid_blocks);
}
```

```cpp
#include <hip/hip_runtime.h>
#include <hip/hip_cooperative_groups.h>
#include <cstdio>
namespace cg = cooperative_groups;

#define LAS __attribute__((address_space(3)))
typedef unsigned short bf16_t;
typedef short bf16x8 __attribute__((ext_vector_type(8)));
typedef short bf16x4 __attribute__((ext_vector_type(4)));
typedef float f32x4 __attribute__((ext_vector_type(4)));
typedef unsigned u32x4 __attribute__((ext_vector_type(4)));
typedef unsigned u32x2 __attribute__((ext_vector_type(2)));

constexpr int MX = 65536, MC = 8192, MT = MX + MC, DM = 1024, DFF = 2816, NMOD = 9216;
constexpr int PW = 1536;
constexpr int CATW = 1536;

constexpr size_t SZ_WB13 = (size_t)5632 * 1024 * 2, SZ_WB2 = (size_t)1024 * 2816 * 2;
constexpr size_t OFF_WB13_1 = 0;
constexpr size_t OFF_WB2_1 = OFF_WB13_1 + SZ_WB13;
constexpr size_t OFF_WB13_2 = OFF_WB2_1 + SZ_WB2;
constexpr size_t OFF_WB2_2 = OFF_WB13_2 + SZ_WB13;
constexpr size_t OFF_WBIN = OFF_WB2_2 + SZ_WB2;
constexpr size_t OFF_WSW = OFF_WBIN + (size_t)1536 * 1024 * 2;
constexpr size_t OFF_WOUT3 = OFF_WSW + (size_t)1792 * 1024 * 2;
constexpr size_t OFF_TT = OFF_WOUT3 + (size_t)1024 * 1536 * 2;
constexpr size_t OFF_MOD = OFF_TT + (size_t)2048 * 2048 * 2;
constexpr size_t OFF_ROPE = OFF_MOD + (size_t)33 * 9216 * 4;
constexpr size_t OFF_YCH = OFF_ROPE + 16384;
constexpr size_t OFF_BAR = OFF_YCH + 65536;
constexpr size_t OFF_A = (size_t)80 << 20;
constexpr size_t SZ_A = (size_t)MX * CATW * 2;
constexpr size_t OFF_H = OFF_A + SZ_A;
constexpr size_t SZ_H = (size_t)MT * DFF * 2;
constexpr size_t OFF_P = OFF_H;
constexpr size_t OFF_YT = OFF_P + (size_t)MX * PW * 2;
constexpr size_t OFF_A2E = OFF_YT + (size_t)16384 * 2048 * 2;
constexpr size_t OFF_A2O = OFF_A2E + (size_t)32768 * 1024 * 2;
constexpr size_t OFF_HC = OFF_H + SZ_H;
constexpr size_t OFF_KTZ = OFF_HC + (size_t)MC * DM * 4;
constexpr size_t OFF_VT = OFF_KTZ + (size_t)2 * 256 * MX * 2;
constexpr size_t OFF_KTZC = OFF_VT + (size_t)512 * MX * 2;
constexpr size_t OFF_VTC = OFF_KTZC + (size_t)2 * 256 * MC * 2;
constexpr size_t OFF_H2B = OFF_KTZ;
constexpr size_t WS_END = OFF_VTC + (size_t)512 * MC * 2;
static_assert(OFF_BAR + 3456 * 4 <= OFF_A, "weights region overflow");
static_assert(OFF_A2O + (size_t)32768 * 1024 * 2 <= OFF_HC, "mix buffers overflow H region");

constexpr int XCD_BAR_WORDS_C = 3456;
constexpr int LDS_BYTES = 131072 + 16;

struct Params {
    const float *x, *c, *ctx, *c_ctx, *w_mod, *b_mod, *norm_ffn1, *w13_1, *w2_1, *norm_mix, *w_in, *ret_log_decay, *w_out, *norm_ffn2, *w13_2, *w2_2, *norm_final;
    float* out; unsigned char* ws;
};

__device__ __forceinline__ unsigned cvt_pk_bf16(float lo, float hi) { unsigned r; asm volatile("v_cvt_pk_bf16_f32 %0, %1, %2" : "=v"(r) : "v"(lo), "v"(hi)); return r; }
__device__ __forceinline__ float bf_lo(unsigned u) { return __uint_as_float(u << 16); }
__device__ __forceinline__ float bf_hi(unsigned u) { return __uint_as_float(u & 0xffff0000u); }
__device__ __forceinline__ float silu_f(float a) { return a * __builtin_amdgcn_rcpf(1.0f + __expf(-a)); }

namespace pg8 {
constexpr int BM = 256, BK = 64, HALF = 128, HTB = HALF * BK * 2, STAGE_BYTES = 8 * HTB, NXCD = 8, WGM = 8;
__device__ __forceinline__ int lds_byte(int r, int c) { const int st = (r >> 4) * 2 + (c >> 5), rr = r & 15, cc = c & 31, ob = rr * 64 + cc * 2; return st * 1024 + (ob ^ (((ob >> 9) & 1) << 5)); }
__device__ __forceinline__ void stage_rc(int b, int& R, int& C) { const int st = b / 1024, sb = b % 1024, swz = sb ^ (((sb >> 9) & 1) << 5); R = (st >> 1) * 16 + swz / 64; C = (st & 1) * 32 + (swz % 64) / 2; }
__device__ __forceinline__ int perm32(int rho) { const int n = rho >> 4, i = rho & 15; return 8 * (i >> 2) + 4 * n + (i & 3); }
struct Unit { int pm, pn; };
struct Gemm { const bf16_t* A; const bf16_t* Bt; int M, N, K; };
struct StaticOrder {
    int nM, nN, nwg, G, c, rev;
    __device__ void init(int M, int N, int G_, int c_, int rev_ = 0) { nM = M / BM; nN = N / BM; nwg = nM * nN; G = G_; c = c_; rev = rev_; }
    __device__ bool next(int i, Unit& u) const {
        const long L = (long)i * G + c; if (L >= nwg) return false;
        int wgid = rev ? (int)(nwg - 1 - L) : (int)L; { const int q = nwg / NXCD, r = nwg % NXCD, xcd = wgid % NXCD, off = wgid / NXCD; wgid = (xcd < r ? xcd * (q + 1) : r * (q + 1) + (xcd - r) * q) + off; }
        const int nig = WGM * nN, gid = wgid / nig, fm = gid * WGM, gsz = (nM - fm) < WGM ? (nM - fm) : WGM;
        u.pm = fm + ((wgid % nig) % gsz); u.pn = (wgid % nig) / gsz; return true;
    }
};

template <class Epi, class Sched>
__device__ __forceinline__ void gemm_phase(LAS unsigned char* lds, const Gemm g, const Sched& S, const Epi& E) {
    int tid_ = threadIdx.x; asm volatile("" : "+v"(tid_));
    const int tid = tid_, wid = __builtin_amdgcn_readfirstlane(tid >> 6), lane = tid & 63, wr = wid >> 2, wc = wid & 3, fr = lane & 15, fq = lane >> 4;
    const int K = g.K, nt = K / BK;
    unsigned voffA[2], voffB[2];
#pragma unroll
    for (int i = 0; i < 2; ++i) { int R, C; stage_rc(tid * 16 + i * 8192, R, C); const int Rb = Epi::PERM ? ((R & ~31) + perm32(R & 31)) : R;
        voffA[i] = (unsigned)(R * K + C) * 2u; voffB[i] = (unsigned)(Rb * K + C) * 2u; }
    const size_t kstep = (size_t)(BK * 2);
    const size_t hstep = (size_t)HALF * K * 2;
    const size_t tstep = 2 * hstep;
    const unsigned ldsw = (unsigned)wid * 1024u;
    const int aoff = lds_byte(wr * 64 + fr, fq * 8), boff = lds_byte(wc * 32 + fr, fq * 8);
#define PG8_SA(b, h) (((b) * 2 + (h)) * HTB)
#define PG8_SB(b, h) ((4 + (b) * 2 + (h)) * HTB)
#define PG8_STAGE(bufoff, gbase, voff) do { _Pragma("unroll") for (int _i = 0; _i < 2; ++_i) \
        __builtin_amdgcn_global_load_lds((const unsigned*)((const char*)(gbase) + (voff)[_i]), (LAS unsigned*)(lds + (bufoff) + ldsw + _i * 8192), 16, 0, 0); } while (0)
#define PG8_LDA(dst, b, h) do { _Pragma("unroll") for (int m = 0; m < 4; ++m) _Pragma("unroll") for (int k = 0; k < 2; ++k) dst[m][k] = *(const LAS bf16x8*)(lds + PG8_SA(b, h) + aoff + m * 2048 + k * 1024); } while (0)
#define PG8_LDB(dst, b, h) do { _Pragma("unroll") for (int n = 0; n < 2; ++n) _Pragma("unroll") for (int k = 0; k < 2; ++k) dst[n][k] = *(const LAS bf16x8*)(lds + PG8_SB(b, h) + boff + n * 2048 + k * 1024); } while (0)
#define PG8_MMA(ai, bj, At, Bt) do { __builtin_amdgcn_s_setprio(1); _Pragma("unroll") for (int m = 0; m < 4; ++m) _Pragma("unroll") for (int n = 0; n < 2; ++n) _Pragma("unroll") for (int k = 0; k < 2; ++k) \
        acc[ai][bj][m][n] = __builtin_amdgcn_mfma_f32_16x16x32_bf16(Bt[n][k], At[m][k], acc[ai][bj][m][n], 0, 0, 0); __builtin_amdgcn_s_setprio(0); } while (0)
#define PG8_WAIT_V(n) asm volatile("s_waitcnt vmcnt(" #n ")" ::: "memory")
#define PG8_WAIT_L(n) asm volatile("s_waitcnt lgkmcnt(" #n ")" ::: "memory")
#define PG8_BAR __builtin_amdgcn_s_barrier()
#define PG8_SCHED __builtin_amdgcn_sched_barrier(0)
    Unit cur, nxt; int ui = 0;
    if (!S.next(0, cur)) return;
    f32x4 acc[2][2][4][2];
#pragma unroll
    for (int a = 0; a < 2; ++a)
#pragma unroll
        for (int b = 0; b < 2; ++b)
#pragma unroll
            for (int m = 0; m < 4; ++m)
#pragma unroll
                for (int n = 0; n < 2; ++n) acc[a][b][m][n] = (f32x4){0.f, 0.f, 0.f, 0.f};
    bf16x8 At[4][2], B0[2][2], B1[2][2];
    const char* cA = (const char*)g.A + (size_t)cur.pm * tstep; const char* cB = (const char*)g.Bt + (size_t)cur.pn * tstep;
    PG8_STAGE(PG8_SB(0, 0), cB, voffB); PG8_STAGE(PG8_SA(0, 0), cA, voffA); PG8_STAGE(PG8_SB(0, 1), cB + hstep, voffB); PG8_STAGE(PG8_SA(0, 1), cA + hstep, voffA);
    if (wr == 1) PG8_BAR;
    PG8_WAIT_V(4); PG8_BAR;
    PG8_STAGE(PG8_SB(1, 0), cB + kstep, voffB); PG8_STAGE(PG8_SA(1, 0), cA + kstep, voffA); PG8_STAGE(PG8_SB(1, 1), cB + hstep + kstep, voffB);
    PG8_WAIT_V(6); PG8_BAR;
    for (;;) {
        const bool has_next = S.next(ui + 1, nxt);
        const char* nA = has_next ? (const char*)g.A + (size_t)nxt.pm * tstep : cA; const char* nB = has_next ? (const char*)g.Bt + (size_t)nxt.pn * tstep : cB;
        for (int t = 0; t < nt; t += 2) {
            const bool last = (t == nt - 2);
            const char* a1 = cA + (size_t)(t + 1) * kstep;
            const char* a2 = last ? nA : cA + (size_t)(t + 2) * kstep; const char* b2 = last ? nB : cB + (size_t)(t + 2) * kstep;
            const char* a3 = a2 + kstep; const char* b3 = b2 + kstep;
            PG8_LDB(B0, 0, 0); PG8_SCHED; PG8_LDA(At, 0, 0); PG8_STAGE(PG8_SA(1, 1), a1 + hstep, voffA);
            PG8_WAIT_L(8); PG8_BAR; PG8_WAIT_L(0); PG8_MMA(0, 0, At, B0); PG8_BAR; PG8_SCHED;
            PG8_LDB(B1, 0, 1); PG8_STAGE(PG8_SB(0, 0), b2, voffB);
            PG8_BAR; PG8_WAIT_L(0); PG8_MMA(0, 1, At, B1); PG8_BAR;
            PG8_LDA(At, 0, 1); PG8_STAGE(PG8_SA(0, 0), a2, voffA);
            PG8_BAR; PG8_WAIT_L(0); PG8_MMA(1, 0, At, B0); PG8_BAR; PG8_SCHED;
            PG8_STAGE(PG8_SB(0, 1), b2 + hstep, voffB);
            PG8_WAIT_V(6); PG8_BAR; PG8_MMA(1, 1, At, B1); PG8_BAR;
            PG8_LDB(B0, 1, 0); PG8_SCHED; PG8_LDA(At, 1, 0); PG8_STAGE(PG8_SA(0, 1), a2 + hstep, voffA);
            PG8_WAIT_L(8); PG8_BAR; PG8_WAIT_L(0); PG8_MMA(0, 0, At, B0); PG8_BAR; PG8_SCHED;
            PG8_LDB(B1, 1, 1); PG8_STAGE(PG8_SB(1, 0), b3, voffB);
            PG8_BAR; PG8_WAIT_L(0); PG8_MMA(0, 1, At, B1); PG8_BAR;
            PG8_LDA(At, 1, 1); PG8_STAGE(PG8_SA(1, 0), a3, voffA);
            PG8_BAR; PG8_WAIT_L(0); PG8_MMA(1, 0, At, B0); PG8_BAR; PG8_SCHED;
            PG8_STAGE(PG8_SB(1, 1), b3 + hstep, voffB);
            PG8_WAIT_V(6); PG8_BAR; PG8_MMA(1, 1, At, B1); PG8_BAR;
        }
        E(acc, cur, wr, wc, fr, fq);
        if (!has_next) break;
#pragma unroll
        for (int a = 0; a < 2; ++a)
#pragma unroll
            for (int b = 0; b < 2; ++b)
#pragma unroll
                for (int m = 0; m < 4; ++m)
#pragma unroll
                    for (int n = 0; n < 2; ++n) acc[a][b][m][n] = (f32x4){0.f, 0.f, 0.f, 0.f};
        cur = nxt; cA = nA; cB = nB; ++ui;
    }
    PG8_WAIT_V(0);
    if (wr == 0) PG8_BAR;
    PG8_BAR;
#undef PG8_SA
#undef PG8_SB
#undef PG8_STAGE
#undef PG8_LDA
#undef PG8_LDB
#undef PG8_MMA
#undef PG8_WAIT_V
#undef PG8_WAIT_L
#undef PG8_BAR
#undef PG8_SCHED
}
}
using pg8::Unit;
typedef f32x4 AccT[2][2][4][2];


struct EpiSwiGLU {
    static constexpr bool PERM = true;
    bf16_t* H;
    __device__ __forceinline__ void operator()(const AccT& acc, const Unit& u, int wr, int wc, int fr, int fq) const {
        asm volatile("" : "+v"(fr), "+v"(fq));
        const int row0 = u.pm * 256 + wr * 64 + fr, hc0 = u.pn * 128 + wc * 32 + 8 * fq;
#pragma unroll
        for (int ai = 0; ai < 2; ++ai)
#pragma unroll
            for (int m = 0; m < 4; ++m) {
                const f32x4 a0 = acc[ai][0][m][0], a1 = acc[ai][0][m][1], b0 = acc[ai][1][m][0], b1 = acc[ai][1][m][1];
                u32x4 w;
                w.x = cvt_pk_bf16(silu_f(a0[0]) * b0[0], silu_f(a0[1]) * b0[1]); w.y = cvt_pk_bf16(silu_f(a0[2]) * b0[2], silu_f(a0[3]) * b0[3]);
                w.z = cvt_pk_bf16(silu_f(a1[0]) * b1[0], silu_f(a1[1]) * b1[1]); w.w = cvt_pk_bf16(silu_f(a1[2]) * b1[2], silu_f(a1[3]) * b1[3]);
                *(u32x4*)(H + (size_t)(row0 + ai * 128 + m * 16) * DFF + hc0) = w;
            }
    }
};

struct EpiResid {
    static constexpr bool PERM = false;
    const float* res_x; const float* res_c; float* out_x; float* out_c; const float* gate; float gs;
    __device__ __forceinline__ void operator()(const AccT& acc, const Unit& u, int wr, int wc, int fr, int fq) const {
        asm volatile("" : "+v"(fr), "+v"(fq));
        const int rowt = u.pm * 256; const bool isc = rowt >= MX;
        const int b = isc ? 32 : (rowt >> 11);
        const float* res = isc ? res_c + (size_t)(rowt - MX) * DM : res_x + (size_t)rowt * DM;
        float* out = isc ? out_c + (size_t)(rowt - MX) * DM : out_x + (size_t)rowt * DM;
        const int col0 = u.pn * 256 + wc * 32 + 4 * fq;
        f32x4 gv[2][2];
#pragma unroll
        for (int bj = 0; bj < 2; ++bj)
#pragma unroll
            for (int n = 0; n < 2; ++n) gv[bj][n] = *(const f32x4*)(gate + (size_t)b * NMOD + col0 + bj * 128 + n * 16) * gs;
#pragma unroll
        for (int ai = 0; ai < 2; ++ai) {
            const size_t ro = (size_t)(wr * 64 + fr + ai * 128) * DM + col0;
            f32x4 r[4][2][2];
#pragma unroll
            for (int m = 0; m < 4; ++m)
#pragma unroll
                for (int bj = 0; bj < 2; ++bj)
#pragma unroll
                    for (int n = 0; n < 2; ++n) r[m][bj][n] = *(const f32x4*)(res + ro + (size_t)m * 16 * DM + bj * 128 + n * 16);
#pragma unroll
            for (int m = 0; m < 4; ++m)
#pragma unroll
                for (int bj = 0; bj < 2; ++bj)
#pragma unroll
                    for (int n = 0; n < 2; ++n) *(f32x4*)(out + ro + (size_t)m * 16 * DM + bj * 128 + n * 16) = r[m][bj][n] + gv[bj][n] * acc[ai][bj][m][n];
        }
    }
};

struct EpiResidBf {
    static constexpr bool PERM = true;
    const float* res_x; bf16_t* hb; const float* gate; float gs;
    __device__ __forceinline__ void operator()(const AccT& acc, const Unit& u, int wr, int wc, int fr, int fq) const {
        asm volatile("" : "+v"(fr), "+v"(fq));
        const int rowt = u.pm * 256; const int b = rowt >> 11;
        const float* res = res_x + (size_t)rowt * DM; bf16_t* out = hb + (size_t)rowt * DM;
        const int col0 = u.pn * 256 + wc * 32 + 8 * fq;
        f32x4 gv[2][2];
#pragma unroll
        for (int bj = 0; bj < 2; ++bj)
#pragma unroll
            for (int n = 0; n < 2; ++n) gv[bj][n] = *(const f32x4*)(gate + (size_t)b * NMOD + col0 + bj * 128 + n * 4) * gs;
#pragma unroll
        for (int ai = 0; ai < 2; ++ai) {
            const size_t ro = (size_t)(wr * 64 + fr + ai * 128) * DM + col0;
            f32x4 r[4][2][2];
#pragma unroll
            for (int m = 0; m < 4; ++m)
#pragma unroll
                for (int bj = 0; bj < 2; ++bj)
#pragma unroll
                    for (int n = 0; n < 2; ++n) r[m][bj][n] = *(const f32x4*)(res + ro + (size_t)m * 16 * DM + bj * 128 + n * 4);
#pragma unroll
            for (int m = 0; m < 4; ++m)
#pragma unroll
                for (int bj = 0; bj < 2; ++bj) {
                    const f32x4 h0 = r[m][bj][0] + gv[bj][0] * acc[ai][bj][m][0], h1 = r[m][bj][1] + gv[bj][1] * acc[ai][bj][m][1];
                    u32x4 w; w.x = cvt_pk_bf16(h0[0], h0[1]); w.y = cvt_pk_bf16(h0[2], h0[3]); w.z = cvt_pk_bf16(h1[0], h1[1]); w.w = cvt_pk_bf16(h1[2], h1[3]);
                    *(u32x4*)(out + ro + (size_t)m * 16 * DM + bj * 128) = w;
                }
        }
    }
};

struct EpiResidBfBf {
    static constexpr bool PERM = true;
    const bf16_t* res_b; bf16_t* hb; const float* gate; float gs;
    __device__ __forceinline__ void operator()(const AccT& acc, const Unit& u, int wr, int wc, int fr, int fq) const {
        asm volatile("" : "+v"(fr), "+v"(fq));
        const int rowt = u.pm * 256; const int b = rowt >> 11;
        const bf16_t* res = res_b + (size_t)rowt * DM; bf16_t* out = hb + (size_t)rowt * DM;
        const int col0 = u.pn * 256 + wc * 32 + 8 * fq;
        f32x4 gv[2][2];
#pragma unroll
        for (int bj = 0; bj < 2; ++bj)
#pragma unroll
            for (int n = 0; n < 2; ++n) gv[bj][n] = *(const f32x4*)(gate + (size_t)b * NMOD + col0 + bj * 128 + n * 4) * gs;
        u32x4 r[2][4][2];
#pragma unroll
        for (int ai = 0; ai < 2; ++ai)
#pragma unroll
            for (int m = 0; m < 4; ++m)
#pragma unroll
                for (int bj = 0; bj < 2; ++bj) r[ai][m][bj] = *(const u32x4*)(res + (size_t)(wr * 64 + fr + ai * 128 + m * 16) * DM + col0 + bj * 128);
#pragma unroll
        for (int ai = 0; ai < 2; ++ai)
#pragma unroll
            for (int m = 0; m < 4; ++m)
#pragma unroll
                for (int bj = 0; bj < 2; ++bj) {
                    const u32x4 q = r[ai][m][bj];
                    const f32x4 r0 = {bf_lo(q.x), bf_hi(q.x), bf_lo(q.y), bf_hi(q.y)}, r1 = {bf_lo(q.z), bf_hi(q.z), bf_lo(q.w), bf_hi(q.w)};
                    const f32x4 h0 = r0 + gv[bj][0] * acc[ai][bj][m][0], h1 = r1 + gv[bj][1] * acc[ai][bj][m][1];
                    u32x4 w; w.x = cvt_pk_bf16(h0[0], h0[1]); w.y = cvt_pk_bf16(h0[2], h0[3]); w.z = cvt_pk_bf16(h1[0], h1[1]); w.w = cvt_pk_bf16(h1[2], h1[3]);
                    *(u32x4*)(out + (size_t)(wr * 64 + fr + ai * 128 + m * 16) * DM + col0 + bj * 128) = w;
                }
    }
};

struct EpiResidBfC {
    static constexpr bool PERM = true;
    const float* res_x; const float* res_c; bf16_t* hb; const float* gate; float gs;
    __device__ __forceinline__ void operator()(const AccT& acc, const Unit& u, int wr, int wc, int fr, int fq) const {
        asm volatile("" : "+v"(fr), "+v"(fq));
        const int rowt = u.pm * 256; const bool isc = rowt >= MX; const int b = isc ? 32 : (rowt >> 11);
        const float* res = isc ? res_c + (size_t)(rowt - MX) * DM : res_x + (size_t)rowt * DM; bf16_t* out = hb + (size_t)rowt * DM;
        const int col0 = u.pn * 256 + wc * 32 + 8 * fq;
        f32x4 gv[2][2];
#pragma unroll
        for (int bj = 0; bj < 2; ++bj)
#pragma unroll
            for (int n = 0; n < 2; ++n) gv[bj][n] = *(const f32x4*)(gate + (size_t)b * NMOD + col0 + bj * 128 + n * 4) * gs;
#pragma unroll
        for (int ai = 0; ai < 2; ++ai) {
            const size_t ro = (size_t)(wr * 64 + fr + ai * 128) * DM + col0;
            f32x4 r[4][2][2];
#pragma unroll
            for (int m = 0; m < 4; ++m)
#pragma unroll
                for (int bj = 0; bj < 2; ++bj)
#pragma unroll
                    for (int n = 0; n < 2; ++n) r[m][bj][n] = *(const f32x4*)(res + ro + (size_t)m * 16 * DM + bj * 128 + n * 4);
#pragma unroll
            for (int m = 0; m < 4; ++m)
#pragma unroll
                for (int bj = 0; bj < 2; ++bj) {
                    const f32x4 h0 = r[m][bj][0] + gv[bj][0] * acc[ai][bj][m][0], h1 = r[m][bj][1] + gv[bj][1] * acc[ai][bj][m][1];
                    u32x4 w; w.x = cvt_pk_bf16(h0[0], h0[1]); w.y = cvt_pk_bf16(h0[2], h0[3]); w.z = cvt_pk_bf16(h1[0], h1[1]); w.w = cvt_pk_bf16(h1[2], h1[3]);
                    *(u32x4*)(out + ro + (size_t)m * 16 * DM + bj * 128) = w;
                }
        }
    }
};

struct EpiInProj {
    static constexpr bool PERM = true;
    bf16_t* P; const float* ropeA;
    bf16_t* KTZ; const float* lgd;
    __device__ __forceinline__ void operator()(const AccT& acc, const Unit& u, int wr, int wc, int fr, int fq) const {
        asm volatile("" : "+v"(fr), "+v"(fq));
        const int row0 = u.pm * 256 + wr * 64 + fr, col0 = u.pn * 256 + wc * 32 + 8 * fq;
        const bool rope = u.pn < 2, ktile = u.pn == 1;
        const int i = 4 * (wc & 1) + fq;
#pragma unroll
        for (int ai = 0; ai < 2; ++ai)
#pragma unroll
            for (int m = 0; m < 4; ++m) {
                const int row = row0 + ai * 128 + m * 16;
                f32x4 cs = {1.f, 1.f, 1.f, 1.f}, sn = {0.f, 0.f, 0.f, 0.f};
                if (rope) { const int t = row & 2047; const int pos = (i < 4) ? (t >> 6) : (t & 63);
                    cs = *(const f32x4*)(ropeA + pos * 16 + ((4 * i) & 15)); sn = *(const f32x4*)(ropeA + 1024 + pos * 16 + ((4 * i) & 15)); }
#pragma unroll
                for (int bj = 0; bj < 2; ++bj) {
                    const f32x4 t1 = acc[ai][bj][m][0], t2 = acc[ai][bj][m][1];
                    f32x4 o1 = t1 * cs - t2 * sn, o2 = t2 * cs + t1 * sn;
                    if (!rope) {
#pragma unroll
                        for (int jj = 0; jj < 4; ++jj) { o1[jj] = silu_f(t1[jj]); o2[jj] = silu_f(t2[jj]); }
                    }
                    u32x4 w; w.x = cvt_pk_bf16(o1[0], o1[1]); w.y = cvt_pk_bf16(o1[2], o1[3]); w.z = cvt_pk_bf16(o2[0], o2[1]); w.w = cvt_pk_bf16(o2[2], o2[3]);
                    *(u32x4*)(P + (size_t)row * PW + col0 + bj * 128) = w;
                    if (ktile) {
                        const int hh = 2 * bj + (wc >> 1), o = wr * 64 + fr + m * 16;
                        const float zf = exp2f((float)(127 - o) * (lgd[hh] * 1.4426950408889634f)), zb = exp2f((float)o * (lgd[4 + hh] * 1.4426950408889634f));
                        bf16_t* kf = KTZ + (size_t)(wc * 32 + 8 * fq + bj * 128) * MX + row; bf16_t* kb = kf + (size_t)256 * MX;
#pragma unroll
                        for (int e = 0; e < 8; ++e) { const float v = e < 4 ? o1[e & 3] : o2[e & 3]; const unsigned pk = cvt_pk_bf16(v * zf, v * zb);
                            kf[(size_t)e * MX] = (bf16_t)(pk & 0xffffu); kb[(size_t)e * MX] = (bf16_t)(pk >> 16); }
                    }
                }
            }
    }
};

template <bool ROPE> struct EpiSwapK {
    static constexpr bool PERM = true;
    bf16_t* KTZ; const float* ropeA; const float* lgd; int NT;
    __device__ __forceinline__ void operator()(const AccT& acc, const Unit& u, int wr, int wc, int fr, int fq) const {
        asm volatile("" : "+v"(fr), "+v"(fq));
        const int rbase = wr * 64 + fr;
        const int tb = u.pn * 256 + wc * 32 + 8 * fq;
        const int o0 = wc * 32 + 8 * fq;
        const int j = fr & 3; const float sgn = ((fr >> 2) & 1) ? 1.0f : -1.0f;
#pragma unroll
        for (int ai = 0; ai < 2; ++ai) {
            const int hh = 2 * ai + wr;
            const float l2f = lgd[hh] * 1.4426950408889634f, l2b = lgd[4 + hh] * 1.4426950408889634f;
            const float zf0 = exp2f((float)(127 - o0) * l2f), zfs = exp2f(-l2f), zb0 = exp2f((float)o0 * l2b), zbs = exp2f(l2b);
#pragma unroll
            for (int m = 0; m < 4; ++m) {
                const int r = rbase + ai * 128 + m * 16;
                const int d = 4 * (2 * m + (fr >> 3)) + j;
#pragma unroll
                for (int bj = 0; bj < 2; ++bj) {
                    const int t0 = tb + bj * 128;
                    float v[8];
#pragma unroll
                    for (int jj = 0; jj < 4; ++jj) { v[jj] = acc[ai][bj][m][0][jj]; v[4 + jj] = acc[ai][bj][m][1][jj]; }
                    if constexpr (ROPE) {
                        const int t = t0 & 2047;
#pragma unroll
                        for (int hf = 0; hf < 2; ++hf) {
                            f32x4 cs, sn;
                            if (m < 2) { const float c1 = ropeA[(t >> 6) * 16 + d], s1 = ropeA[1024 + (t >> 6) * 16 + d]; cs = (f32x4){c1, c1, c1, c1}; sn = (f32x4){s1, s1, s1, s1}; }
                            else { const float* cb = ropeA + 2048 + (d - 16) * 64 + (t & 63) + 4 * hf; cs = *(const f32x4*)(cb); sn = *(const f32x4*)(cb + 1024); }
#pragma unroll
                            for (int jj = 0; jj < 4; ++jj) { const float pr = __shfl_xor(v[4 * hf + jj], 4); v[4 * hf + jj] = v[4 * hf + jj] * cs[jj] + sgn * pr * sn[jj]; }
                            __builtin_amdgcn_sched_barrier(0);
                        }
                    }
                    float zf[8], zb[8]; zf[0] = zf0; zb[0] = zb0;
#pragma unroll
                    for (int jj = 1; jj < 8; ++jj) { zf[jj] = zf[jj - 1] * zfs; zb[jj] = zb[jj - 1] * zbs; }
                    u32x4 wf, wb;
                    wf.x = cvt_pk_bf16(v[0] * zf[0], v[1] * zf[1]); wf.y = cvt_pk_bf16(v[2] * zf[2], v[3] * zf[3]); wf.z = cvt_pk_bf16(v[4] * zf[4], v[5] * zf[5]); wf.w = cvt_pk_bf16(v[6] * zf[6], v[7] * zf[7]);
                    wb.x = cvt_pk_bf16(v[0] * zb[0], v[1] * zb[1]); wb.y = cvt_pk_bf16(v[2] * zb[2], v[3] * zb[3]); wb.z = cvt_pk_bf16(v[4] * zb[4], v[5] * zb[5]); wb.w = cvt_pk_bf16(v[6] * zb[6], v[7] * zb[7]);
                    *(u32x4*)(KTZ + (size_t)r * NT + t0) = wf;
                    *(u32x4*)(KTZ + (size_t)(256 + r) * NT + t0) = wb;
                    __builtin_amdgcn_sched_barrier(0);
                }
            }
        }
    }
};
struct EpiSwapVF {
    static constexpr bool PERM = true;
    bf16_t* VT; int NT;
    __device__ __forceinline__ void operator()(const AccT& acc, const Unit& u, int wr, int wc, int fr, int fq) const {
        asm volatile("" : "+v"(fr), "+v"(fq));
        const int rbase = u.pm * 256 + wr * 64 + fr;
        const int tb = u.pn * 256 + wc * 32 + 8 * fq;
#pragma unroll
        for (int ai = 0; ai < 2; ++ai)
#pragma unroll
            for (int m = 0; m < 4; ++m) {
                const int r = rbase + ai * 128 + m * 16;
#pragma unroll
                for (int bj = 0; bj < 2; ++bj) {
                    const int t0 = tb + bj * 128;
                    const f32x4 v0 = acc[ai][bj][m][0], v1 = acc[ai][bj][m][1];
                    u32x4 w; w.x = cvt_pk_bf16(v0[0], v0[1]); w.y = cvt_pk_bf16(v0[2], v0[3]); w.z = cvt_pk_bf16(v1[0], v1[1]); w.w = cvt_pk_bf16(v1[2], v1[3]);
                    *(u32x4*)(VT + (size_t)r * NT + t0) = w;
                }
            }
    }
};
struct EpiSwapF {
    static constexpr bool PERM = true;
    bf16_t* YT; int part;
    __device__ __forceinline__ void operator()(const AccT& acc, const Unit& u, int wr, int wc, int fr, int fq) const {
        asm volatile("" : "+v"(fr), "+v"(fq));
        const int rbase = u.pm * 256 + wr * 64 + fr;
        const int tb = u.pn * 256 + wc * 32 + 8 * fq;
#pragma unroll
        for (int ai = 0; ai < 2; ++ai)
#pragma unroll
            for (int m = 0; m < 4; ++m) {
                const int gm = rbase + ai * 128 + m * 16;
#pragma unroll
                for (int bj = 0; bj < 2; ++bj) {
                    const int t0 = tb + bj * 128;
                    const f32x4 v0 = acc[ai][bj][m][0], v1 = acc[ai][bj][m][1];
                    u32x4 w; w.x = cvt_pk_bf16(v0[0], v0[1]); w.y = cvt_pk_bf16(v0[2], v0[3]); w.z = cvt_pk_bf16(v1[0], v1[1]); w.w = cvt_pk_bf16(v1[2], v1[3]);
                    *(u32x4*)(YT + ((size_t)((t0 >> 10) * 512 + gm)) * 2048 + part * 1024 + (t0 & 1023)) = w;
                }
            }
    }
};

struct EpiFour {
    static constexpr bool PERM = true;
    bf16_t* CAT; const float* YCH;
    __device__ __forceinline__ void operator()(const AccT& acc, const Unit& u, int wr, int wc, int fr, int fq) const {
        asm volatile("" : "+v"(fr), "+v"(fq));
        const int row0 = u.pm * 256 + wr * 64 + fr; const int b = u.pn >> 1, ch0 = (u.pn & 1) * 256 + wc * 32 + 8 * fq;
        const float sg = (fr & 1) ? -1.0f : 1.0f;
        f32x4 yh[2][2];
#pragma unroll
        for (int bj = 0; bj < 2; ++bj)
#pragma unroll
            for (int n = 0; n < 2; ++n) yh[bj][n] = *(const f32x4*)(YCH + b * 512 + ch0 + bj * 128 + 4 * n) * sg;
#pragma unroll
        for (int ai = 0; ai < 2; ++ai)
#pragma unroll
            for (int m = 0; m < 4; ++m) {
                const int k = row0 + ai * 128 + m * 16;
#pragma unroll
                for (int bj = 0; bj < 2; ++bj) {
                    const f32x4 v0 = acc[ai][bj][m][0] + yh[bj][0], v1 = acc[ai][bj][m][1] + yh[bj][1];
                    u32x4 w; w.x = cvt_pk_bf16(v0[0], v0[1]); w.y = cvt_pk_bf16(v0[2], v0[3]); w.z = cvt_pk_bf16(v1[0], v1[1]); w.w = cvt_pk_bf16(v1[2], v1[3]);
                    *(u32x4*)(CAT + (size_t)(b * 2048 + k) * CATW + 1024 + ch0 + bj * 128) = w;
                }
            }
    }
};

template <class Epi>
__device__ __forceinline__ void run_gemm(LAS unsigned char* lds, const bf16_t* A, const bf16_t* Bt, int M, int N, int K, const Epi& E, int rot = 0, int rev = 0) {
    pg8::Gemm g; g.A = A; g.Bt = Bt; g.M = M; g.N = N; g.K = K;
    pg8::StaticOrder S; S.init(M, N, (int)gridDim.x, (int)((blockIdx.x + rot) % gridDim.x), rev);
    pg8::gemm_phase<Epi, pg8::StaticOrder>(lds, g, S, E);
}

__device__ __forceinline__ void prep_tile(unsigned char* shm, const float* src, int sld, int srow0, int scol0, bf16_t* dst, int dld, int r0, int k0, bool perm, float scale) {
    float* tile = (float*)shm;
    const int t = threadIdx.x, tx = t & 127, ty = t >> 7;
    __syncthreads();
    float ld[16];
#pragma unroll
    for (int q = 0; q < 16; ++q) ld[q] = src[(size_t)(srow0 + ty + 4 * q) * sld + scol0 + tx];
#pragma unroll
    for (int q = 0; q < 16; ++q) tile[(ty + 4 * q) * 129 + tx] = ld[q];
    __syncthreads();
    const int rr = t >> 2, ks = (t & 3) * 16;
    const int r6 = rr & 63;
    const int sc = perm ? ((rr & 64) + 32 * ((r6 >> 2) & 1) + 4 * (r6 >> 3) + (r6 & 3)) : rr;
#pragma unroll
    for (int hq = 0; hq < 2; ++hq) {
        float v[8];
#pragma unroll
        for (int q = 0; q < 8; ++q) v[q] = tile[(ks + hq * 8 + q) * 129 + sc] * scale;
        u32x4 w; w.x = cvt_pk_bf16(v[0], v[1]); w.y = cvt_pk_bf16(v[2], v[3]); w.z = cvt_pk_bf16(v[4], v[5]); w.w = cvt_pk_bf16(v[6], v[7]);
        *(u32x4*)(dst + (size_t)(r0 + rr) * dld + k0 + ks + hq * 8) = w;
    }
}

__device__ __forceinline__ void phase_prep(unsigned char* shm, const Params& p, int set, int first, int stride) {
    constexpr int J0 = 704, J1 = J0 + 352, J2 = J1 + 704, J3 = J2 + 352, J4 = J3 + 192, J5 = J4 + 96, J6 = J5 + 192, J7 = J6 + 256, J8 = J7 + 256, J9 = J8 + 144, J10 = J9 + 1;
    unsigned char* ws = p.ws;
    const int tid = threadIdx.x;
    constexpr int V0 = J1 + (J10 - J8), V1 = J8 - J1;
    for (int v = first; v < (set ? V1 : V0); v += stride) {
        const int job = set ? v + J1 : (v < J1 ? v : v - J1 + J8);
        if (job < J0 || (job >= J1 && job < J2)) {
            const bool second = job >= J1; const int jj = second ? job - J1 : job; const int rg = jj >> 4, kb = jj & 15;
            const int pn = rg >> 1, bj = rg & 1;
            prep_tile(shm, second ? p.w13_2 : p.w13_1, 5632, 64 * kb, bj * DFF + 128 * pn, (bf16_t*)(ws + (second ? OFF_WB13_2 : OFF_WB13_1)), 1024, 128 * rg, 64 * kb, false, 1.f);
        } else if (job < J1 || (job >= J2 && job < J3)) {
            const bool second = job >= J2; const int jj = second ? job - J2 : job - J0; const int rg = jj / 44, kb = jj % 44;
            prep_tile(shm, second ? p.w2_2 : p.w2_1, 1024, 64 * kb, 128 * rg, (bf16_t*)(ws + (second ? OFF_WB2_2 : OFF_WB2_1)), DFF, 128 * rg, 64 * kb, false, 1.f);
        } else if (job < J4) {
            const int jj = job - J3, rg = jj >> 4, kb = jj & 15;
            const int sc0 = rg < 4 ? 128 * rg : 128 * rg + 512;
            prep_tile(shm, p.w_in, 2560, 64 * kb, sc0, (bf16_t*)(ws + OFF_WBIN), 1024, 128 * rg, 64 * kb, rg < 4, (rg >= 2 && rg < 4) ? 0.125f : 1.f);
        } else if (job < J5) {
            const int jj = job - J4, rg = jj >> 4, kb = jj & 15;
            const int sc0 = rg < 2 ? 256 + 128 * rg : 512 + 128 * (rg - 2);
            prep_tile(shm, p.w_in, 2560, 64 * kb, sc0, (bf16_t*)(ws + OFF_WSW), 1024, 128 * rg, 64 * kb, rg < 2, rg < 2 ? 0.125f : 1.f);
        } else if (job < J6) {
            const int jj = job - J5, rg = jj / 24, kb = jj % 24;
            prep_tile(shm, p.w_out, 1024, kb < 8 ? 64 * kb : 64 * (kb - 8), 128 * rg, (bf16_t*)(ws + OFF_WOUT3), 1536, 128 * rg, 64 * kb, false, 1.f);
        } else if (job < J7) {
            const int jj = job - J6, g = jj >> 6, k0 = (jj & 63) * 16;
            float* wl = (float*)shm;
            float* trig = wl + 16 * 128;
            __syncthreads();
            for (int q = tid; q < 16 * 128; q += 512) wl[q] = p.w_in[(size_t)(k0 + (q >> 7)) * 2560 + 2048 + g * 128 + (q & 127)];
            if (tid < 128) trig[tid] = cospif((float)tid * (1.0f / 64.0f));
            __syncthreads();
            const int pm = tid & 255, kh = tid >> 8, part = pm >> 7, m = pm & 127;
            float a[8];
#pragma unroll
            for (int q = 0; q < 8; ++q) a[q] = 0.f;
            for (int c = 0; c < 128; ++c) {
                const int idx = (m * c) & 127;
                const float tr = part ? -trig[(idx + 96) & 127] : trig[idx];
#pragma unroll
                for (int q = 0; q < 8; ++q) a[q] += wl[(kh * 8 + q) * 128 + c] * tr;
            }
            u32x4 w; const float sc = 1.0f / 512.0f;
            w.x = cvt_pk_bf16(a[0] * sc, a[1] * sc); w.y = cvt_pk_bf16(a[2] * sc, a[3] * sc); w.z = cvt_pk_bf16(a[4] * sc, a[5] * sc); w.w = cvt_pk_bf16(a[6] * sc, a[7] * sc);
            *(u32x4*)((bf16_t*)(ws + OFF_WSW) + (size_t)(768 + part * 512 + g * 128 + m) * 1024 + k0 + kh * 8) = w;
        } else if (job < J8) {
            const int jj = job - J7; float* ct = (float*)shm;
            __syncthreads();
            for (int q = tid; q < 2048; q += 512) ct[q] = cospif((float)q * (1.0f / 1024.0f));
            __syncthreads();
            bf16_t* TT = (bf16_t*)(ws + OFF_TT);
            for (int q = tid; q < 8 * 256; q += 512) {
                const int k = jj * 8 + (q >> 8), pc = q & 255, part = pc >> 7, n0 = (pc & 127) * 8;
                float v[8];
#pragma unroll
                for (int e = 0; e < 8; ++e) { const int idx = (k * (n0 + e)) & 2047; v[e] = part ? ct[(idx + 1536) & 2047] : ct[idx]; }
                u32x4 w; w.x = cvt_pk_bf16(v[0], v[1]); w.y = cvt_pk_bf16(v[2], v[3]); w.z = cvt_pk_bf16(v[4], v[5]); w.w = cvt_pk_bf16(v[6], v[7]);
                *(u32x4*)(TT + (size_t)k * 2048 + part * 1024 + n0) = w;
            }
        } else if (job < J9) {
            const int jj = job - J8, col0 = jj * 64; const int wid = tid >> 6, lane = tid & 63;
            float acc[33];
#pragma unroll
            for (int b = 0; b < 33; ++b) acc[b] = 0.f;
            for (int kc = 0; kc < 2; ++kc) {
                const int kb = wid * 128 + kc * 64;
                float cv[33];
#pragma unroll
                for (int b = 0; b < 33; ++b) { const float cc = (b < 32) ? p.c[b * DM + kb + lane] : p.c_ctx[kb + lane]; cv[b] = cc / (1.0f + expf(-cc)); }
#pragma unroll 4
                for (int kk = 0; kk < 64; ++kk) {
                    const float wv = p.w_mod[(size_t)(kb + kk) * NMOD + col0 + lane];
#pragma unroll
                    for (int b = 0; b < 33; ++b) acc[b] += __uint_as_float(__builtin_amdgcn_readlane(__float_as_uint(cv[b]), kk)) * wv;
                }
            }
            float* red = (float*)shm;
            __syncthreads();
#pragma unroll
            for (int b = 0; b < 33; ++b) red[(wid * 33 + b) * 64 + lane] = acc[b];
            __syncthreads();
            float* mod = (float*)(ws + OFF_MOD);
            for (int q = tid; q < 33 * 64; q += 512) {
                const int b = q >> 6, cl = q & 63; float s = p.b_mod[col0 + cl];
#pragma unroll
                for (int w = 0; w < 8; ++w) s += red[(w * 33 + b) * 64 + cl];
                mod[(size_t)b * NMOD + col0 + cl] = s;
            }
        } else {
            float* R = (float*)(ws + OFF_ROPE);
            for (int q = tid; q < 1024; q += 512) {
                const int pos = q >> 4, f = q & 15;
                const float inv = powf(10000.0f, -(float)f / 16.0f); const float ang = (float)pos * inv;
                const float cs = cosf(ang), sn = sinf(ang);
                R[pos * 16 + f] = cs; R[1024 + pos * 16 + f] = sn; R[2048 + f * 64 + pos] = cs; R[3072 + f * 64 + pos] = sn;
            }
        }
    }
}

template <int R>
__device__ __forceinline__ void phase_norm_mod(const float* src_x, const float* src_c, int nrows, const float* g, const float* mod, int shift_off, int scale_off, bf16_t* dst, int row_begin = 0, bool local = false) {
    int tid_ = threadIdx.x; asm volatile("" : "+v"(tid_));
    const int wid = tid_ >> 6, lane = tid_ & 63;
    const int first = row_begin + (local ? wid : blockIdx.x * 8 * R + wid), step = local ? 8 * R : gridDim.x * 8 * R;
    for (int row0 = first; row0 < nrows; row0 += step) {
        const int b = row0 < MX ? (row0 >> 11) : 32;
        f32x4 v[R][4], gg[4], sc[4], sh[4];
#pragma unroll
        for (int j = 0; j < R; ++j) { const int row = row0 + 8 * j; const float* s = row < MX ? src_x + (size_t)row * DM : src_c + (size_t)(row - MX) * DM;
#pragma unroll
            for (int i = 0; i < 4; ++i) v[j][i] = (row < nrows) ? *(const f32x4*)(s + (i >> 1) * 512 + lane * 8 + (i & 1) * 4) : (f32x4){0.f, 0.f, 0.f, 0.f}; }
#pragma unroll
        for (int i = 0; i < 4; ++i) { const int col = (i >> 1) * 512 + lane * 8 + (i & 1) * 4; gg[i] = *(const f32x4*)(g + col); sc[i] = *(const f32x4*)(mod + (size_t)b * NMOD + scale_off + col) + 1.0f; sh[i] = *(const f32x4*)(mod + (size_t)b * NMOD + shift_off + col); }
#pragma unroll
        for (int j = 0; j < R; ++j) {
            const int row = row0 + 8 * j;
            float ss = 0.f;
#pragma unroll
            for (int i = 0; i < 4; ++i) ss += v[j][i][0] * v[j][i][0] + v[j][i][1] * v[j][i][1] + v[j][i][2] * v[j][i][2] + v[j][i][3] * v[j][i][3];
#pragma unroll
            for (int o = 32; o >= 1; o >>= 1) ss += __shfl_xor(ss, o);
            const float r = rsqrtf(ss * (1.0f / 1024.0f) + 1e-6f);
            if (row < nrows) {
#pragma unroll
                for (int i = 0; i < 4; i += 2) { const f32x4 y0 = (v[j][i] * r) * gg[i] * sc[i] + sh[i], y1 = (v[j][i + 1] * r) * gg[i + 1] * sc[i + 1] + sh[i + 1];
                    u32x4 w; w.x = cvt_pk_bf16(y0[0], y0[1]); w.y = cvt_pk_bf16(y0[2], y0[3]); w.z = cvt_pk_bf16(y1[0], y1[1]); w.w = cvt_pk_bf16(y1[2], y1[3]);
                    *(u32x4*)(dst + (size_t)row * DM + (i >> 1) * 512 + lane * 8) = w; }
            }
        }
    }
}
template <int R>
__device__ __forceinline__ void phase_norm_mod_bf(const bf16_t* src, int nrows, const float* g, const float* mod, int shift_off, int scale_off, bf16_t* dst, int row_begin = 0) {
    int tid_ = threadIdx.x; asm volatile("" : "+v"(tid_));
    const int wid = tid_ >> 6, lane = tid_ & 63;
    for (int row0 = row_begin + blockIdx.x * 8 * R + wid; row0 < nrows; row0 += gridDim.x * 8 * R) {
        const int b = row0 < MX ? (row0 >> 11) : 32;
        u32x4 v[R][2]; f32x4 gg[2][2], sc[2][2], sh[2][2];
#pragma unroll
        for (int j = 0; j < R; ++j)
#pragma unroll
            for (int i = 0; i < 2; ++i) v[j][i] = *(const u32x4*)(src + (size_t)(row0 + 8 * j) * DM + i * 512 + lane * 8);
#pragma unroll
        for (int i = 0; i < 2; ++i)
#pragma unroll
            for (int n = 0; n < 2; ++n) { const int col = i * 512 + lane * 8 + 4 * n; gg[i][n] = *(const f32x4*)(g + col); sc[i][n] = *(const f32x4*)(mod + (size_t)b * NMOD + scale_off + col) + 1.0f; sh[i][n] = *(const f32x4*)(mod + (size_t)b * NMOD + shift_off + col); }
#pragma unroll
        for (int j = 0; j < R; ++j) {
            f32x4 x[2][2]; float ss = 0.f;
#pragma unroll
            for (int i = 0; i < 2; ++i) { x[i][0] = (f32x4){bf_lo(v[j][i].x), bf_hi(v[j][i].x), bf_lo(v[j][i].y), bf_hi(v[j][i].y)}; x[i][1] = (f32x4){bf_lo(v[j][i].z), bf_hi(v[j][i].z), bf_lo(v[j][i].w), bf_hi(v[j][i].w)};
                ss += x[i][0][0] * x[i][0][0] + x[i][0][1] * x[i][0][1] + x[i][0][2] * x[i][0][2] + x[i][0][3] * x[i][0][3] + x[i][1][0] * x[i][1][0] + x[i][1][1] * x[i][1][1] + x[i][1][2] * x[i][1][2] + x[i][1][3] * x[i][1][3]; }
#pragma unroll
            for (int o = 32; o >= 1; o >>= 1) ss += __shfl_xor(ss, o);
            const float r = rsqrtf(ss * (1.0f / 1024.0f) + 1e-6f);
#pragma unroll
            for (int i = 0; i < 2; ++i) { const f32x4 y0 = (x[i][0] * r) * gg[i][0] * sc[i][0] + sh[i][0], y1 = (x[i][1] * r) * gg[i][1] * sc[i][1] + sh[i][1];
                u32x4 w; w.x = cvt_pk_bf16(y0[0], y0[1]); w.y = cvt_pk_bf16(y0[2], y0[3]); w.z = cvt_pk_bf16(y1[0], y1[1]); w.w = cvt_pk_bf16(y1[2], y1[3]);
                *(u32x4*)(dst + (size_t)(row0 + 8 * j) * DM + i * 512 + lane * 8) = w; }
        }
    }
}

__device__ __forceinline__ void phase_norm_mix_pairs(const float* src, const float* g, const float* mod, int shift_off, int scale_off, bf16_t* dst, bf16_t* A2e, bf16_t* A2o) {
    int tid_ = threadIdx.x; asm volatile("" : "+v"(tid_));
    const int wid = tid_ >> 6, lane = tid_ & 63;
    for (int it = blockIdx.x * 8 + wid; it < 32 * 1025; it += gridDim.x * 8) {
        const int b = it / 1025, n = it - b * 1025;
        const bool pair = (n >= 1) && (n <= 1023);
        const int r1 = b * 2048 + n, r2 = pair ? b * 2048 + 2048 - n : r1;
        const float* s1 = src + (size_t)r1 * DM; const float* s2 = src + (size_t)r2 * DM;
        f32x4 v1[4], v2[4], gg[4], sc[4], sh[4]; float ss1 = 0.f, ss2 = 0.f;
#pragma unroll
        for (int i = 0; i < 4; ++i) { v1[i] = *(const f32x4*)(s1 + i * 256 + lane * 4); v2[i] = *(const f32x4*)(s2 + i * 256 + lane * 4); }
#pragma unroll
        for (int i = 0; i < 4; ++i) { const int col = i * 256 + lane * 4; gg[i] = *(const f32x4*)(g + col); sc[i] = *(const f32x4*)(mod + (size_t)b * NMOD + scale_off + col); sh[i] = *(const f32x4*)(mod + (size_t)b * NMOD + shift_off + col); }
#pragma unroll
        for (int i = 0; i < 4; ++i) { ss1 += v1[i][0] * v1[i][0] + v1[i][1] * v1[i][1] + v1[i][2] * v1[i][2] + v1[i][3] * v1[i][3]; ss2 += v2[i][0] * v2[i][0] + v2[i][1] * v2[i][1] + v2[i][2] * v2[i][2] + v2[i][3] * v2[i][3]; }
#pragma unroll
        for (int o = 32; o >= 1; o >>= 1) { ss1 += __shfl_xor(ss1, o); ss2 += __shfl_xor(ss2, o); }
        const float ra = rsqrtf(ss1 * (1.0f / 1024.0f) + 1e-6f), rb = rsqrtf(ss2 * (1.0f / 1024.0f) + 1e-6f);
        u32x2 w1[4], w2[4], we[4], wo[4];
#pragma unroll
        for (int i = 0; i < 4; ++i) {
            const f32x4 y1 = (v1[i] * ra) * gg[i] * (sc[i] + 1.0f) + sh[i], y2 = (v2[i] * rb) * gg[i] * (sc[i] + 1.0f) + sh[i];
            const f32x4 ye = pair ? (y1 + y2) : y1, yo = pair ? (y1 - y2) : (f32x4){0.f, 0.f, 0.f, 0.f};
            w1[i].x = cvt_pk_bf16(y1[0], y1[1]); w1[i].y = cvt_pk_bf16(y1[2], y1[3]); w2[i].x = cvt_pk_bf16(y2[0], y2[1]); w2[i].y = cvt_pk_bf16(y2[2], y2[3]);
            we[i].x = cvt_pk_bf16(ye[0], ye[1]); we[i].y = cvt_pk_bf16(ye[2], ye[3]); wo[i].x = cvt_pk_bf16(yo[0], yo[1]); wo[i].y = cvt_pk_bf16(yo[2], yo[3]);
        }
#pragma unroll
        for (int i = 0; i < 4; ++i) {
            const int col = i * 256 + lane * 4;
            *(u32x2*)(dst + (size_t)r1 * DM + col) = w1[i];
            if (pair) *(u32x2*)(dst + (size_t)r2 * DM + col) = w2[i];
            if (n < 1024) { *(u32x2*)(A2e + ((size_t)b * 1024 + n) * DM + col) = we[i]; *(u32x2*)(A2o + ((size_t)b * 1024 + n) * DM + col) = wo[i]; }
        }
    }
}
__device__ __forceinline__ void phase_norm_mix_pairs_bf(const bf16_t* src, const float* g, const float* mod, int shift_off, int scale_off, bf16_t* dst, bf16_t* A2e, bf16_t* A2o) {
    int tid_ = threadIdx.x; asm volatile("" : "+v"(tid_));
    const int wid = tid_ >> 6, lane = tid_ & 63;
    constexpr int PP = 4, NG = (1025 + PP - 1) / PP;
    for (int gi = blockIdx.x * 8 + wid; gi < 32 * NG; gi += gridDim.x * 8) {
        const int b = gi / NG, n0 = (gi - b * NG) * PP;
        u32x4 v1[PP][2], v2[PP][2]; f32x4 gg[2][2], sc[2][2], sh[2][2];
#pragma unroll
        for (int q = 0; q < PP; ++q) {
            const int n = n0 + q < 1025 ? n0 + q : 1024;
            const bool pair = (n >= 1) && (n <= 1023);
            const int r1 = b * 2048 + n, r2 = pair ? b * 2048 + 2048 - n : r1;
#pragma unroll
            for (int i = 0; i < 2; ++i) { v1[q][i] = *(const u32x4*)(src + (size_t)r1 * DM + i * 512 + lane * 8); v2[q][i] = *(const u32x4*)(src + (size_t)r2 * DM + i * 512 + lane * 8); }
        }
#pragma unroll
        for (int i = 0; i < 2; ++i)
#pragma unroll
            for (int n = 0; n < 2; ++n) { const int col = i * 512 + lane * 8 + 4 * n; gg[i][n] = *(const f32x4*)(g + col); sc[i][n] = *(const f32x4*)(mod + (size_t)b * NMOD + scale_off + col) + 1.0f; sh[i][n] = *(const f32x4*)(mod + (size_t)b * NMOD + shift_off + col); }
#pragma unroll
        for (int q = 0; q < PP; ++q) {
            const int n = n0 + q;
            const bool valid = n < 1025, pair = (n >= 1) && (n <= 1023);
            const int r1 = b * 2048 + n, r2 = b * 2048 + 2048 - n;
            f32x4 x1[2][2], x2[2][2]; float ss1 = 0.f, ss2 = 0.f;
#pragma unroll
            for (int i = 0; i < 2; ++i) {
                x1[i][0] = (f32x4){bf_lo(v1[q][i].x), bf_hi(v1[q][i].x), bf_lo(v1[q][i].y), bf_hi(v1[q][i].y)}; x1[i][1] = (f32x4){bf_lo(v1[q][i].z), bf_hi(v1[q][i].z), bf_lo(v1[q][i].w), bf_hi(v1[q][i].w)};
                x2[i][0] = (f32x4){bf_lo(v2[q][i].x), bf_hi(v2[q][i].x), bf_lo(v2[q][i].y), bf_hi(v2[q][i].y)}; x2[i][1] = (f32x4){bf_lo(v2[q][i].z), bf_hi(v2[q][i].z), bf_lo(v2[q][i].w), bf_hi(v2[q][i].w)};
#pragma unroll
                for (int n2 = 0; n2 < 2; ++n2) { ss1 += x1[i][n2][0] * x1[i][n2][0] + x1[i][n2][1] * x1[i][n2][1] + x1[i][n2][2] * x1[i][n2][2] + x1[i][n2][3] * x1[i][n2][3];
                                                  ss2 += x2[i][n2][0] * x2[i][n2][0] + x2[i][n2][1] * x2[i][n2][1] + x2[i][n2][2] * x2[i][n2][2] + x2[i][n2][3] * x2[i][n2][3]; }
            }
#pragma unroll
            for (int o = 32; o >= 1; o >>= 1) { ss1 += __shfl_xor(ss1, o); ss2 += __shfl_xor(ss2, o); }
            const float ra = rsqrtf(ss1 * (1.0f / 1024.0f) + 1e-6f), rb = rsqrtf(ss2 * (1.0f / 1024.0f) + 1e-6f);
            if (valid) {
#pragma unroll
                for (int i = 0; i < 2; ++i) {
                    const int col = i * 512 + lane * 8;
                    f32x4 y1[2], y2[2], ye[2], yo[2];
#pragma unroll
                    for (int n2 = 0; n2 < 2; ++n2) { y1[n2] = (x1[i][n2] * ra) * gg[i][n2] * sc[i][n2] + sh[i][n2]; y2[n2] = (x2[i][n2] * rb) * gg[i][n2] * sc[i][n2] + sh[i][n2];
                        ye[n2] = pair ? (y1[n2] + y2[n2]) : y1[n2]; yo[n2] = pair ? (y1[n2] - y2[n2]) : (f32x4){0.f, 0.f, 0.f, 0.f}; }
                    u32x4 w1, w2, we, wo;
                    w1.x = cvt_pk_bf16(y1[0][0], y1[0][1]); w1.y = cvt_pk_bf16(y1[0][2], y1[0][3]); w1.z = cvt_pk_bf16(y1[1][0], y1[1][1]); w1.w = cvt_pk_bf16(y1[1][2], y1[1][3]);
                    w2.x = cvt_pk_bf16(y2[0][0], y2[0][1]); w2.y = cvt_pk_bf16(y2[0][2], y2[0][3]); w2.z = cvt_pk_bf16(y2[1][0], y2[1][1]); w2.w = cvt_pk_bf16(y2[1][2], y2[1][3]);
                    we.x = cvt_pk_bf16(ye[0][0], ye[0][1]); we.y = cvt_pk_bf16(ye[0][2], ye[0][3]); we.z = cvt_pk_bf16(ye[1][0], ye[1][1]); we.w = cvt_pk_bf16(ye[1][2], ye[1][3]);
                    wo.x = cvt_pk_bf16(yo[0][0], yo[0][1]); wo.y = cvt_pk_bf16(yo[0][2], yo[0][3]); wo.z = cvt_pk_bf16(yo[1][0], yo[1][1]); wo.w = cvt_pk_bf16(yo[1][2], yo[1][3]);
                    *(u32x4*)(dst + (size_t)r1 * DM + col) = w1;
                    if (pair) *(u32x4*)(dst + (size_t)r2 * DM + col) = w2;
                    if (n < 1024) { *(u32x4*)(A2e + ((size_t)b * 1024 + n) * DM + col) = we; *(u32x4*)(A2o + ((size_t)b * 1024 + n) * DM + col) = wo; }
                }
            }
        }
    }
}

__device__ __forceinline__ void phase_ych(const bf16_t* A2, const bf16_t* Wc, float* YCH) {
    int tid_ = threadIdx.x; asm volatile("" : "+v"(tid_));
    const int wid = tid_ >> 6, lane = tid_ & 63;
    for (int o = blockIdx.x * 8 + wid; o < 32 * 512; o += gridDim.x * 8) {
        const int b = o >> 9, gm = o & 511;
        const bf16_t* a = A2 + ((size_t)b * 2048 + 1024) * DM + lane * 16; const bf16_t* w = Wc + (size_t)gm * DM + lane * 16;
        float acc = 0.f;
#pragma unroll
        for (int q = 0; q < 2; ++q) { const u32x4 av = *(const u32x4*)(a + q * 8), wv = *(const u32x4*)(w + q * 8);
            acc += bf_lo(av.x) * bf_lo(wv.x) + bf_hi(av.x) * bf_hi(wv.x) + bf_lo(av.y) * bf_lo(wv.y) + bf_hi(av.y) * bf_hi(wv.y) + bf_lo(av.z) * bf_lo(wv.z) + bf_hi(av.z) * bf_hi(wv.z) + bf_lo(av.w) * bf_lo(wv.w) + bf_hi(av.w) * bf_hi(wv.w); }
#pragma unroll
        for (int sft = 32; sft >= 1; sft >>= 1) acc += __shfl_xor(acc, sft);
        if (lane == 0) YCH[o] = acc;
    }
}
__device__ __forceinline__ void phase_final_norm(const bf16_t* hb, float* out, const float* g) {
    int tid_ = threadIdx.x; asm volatile("" : "+v"(tid_));
    const int wid = tid_ >> 6, lane = tid_ & 63;
    constexpr int R = 8;
    f32x4 gg[2][2];
#pragma unroll
    for (int i = 0; i < 2; ++i) { gg[i][0] = *(const f32x4*)(g + i * 512 + lane * 8); gg[i][1] = *(const f32x4*)(g + i * 512 + lane * 8 + 4); }
    for (int row0 = blockIdx.x * 8 * R + wid; row0 < MX; row0 += gridDim.x * 8 * R) {
        u32x4 v[R][2];
#pragma unroll
        for (int j = 0; j < R; ++j)
#pragma unroll
            for (int i = 0; i < 2; ++i) v[j][i] = *(const u32x4*)(hb + (size_t)(row0 + 8 * j) * DM + i * 512 + lane * 8);
#pragma unroll
        for (int j = 0; j < R; ++j) {
            f32x4 x[2][2]; float ss = 0.f;
#pragma unroll
            for (int i = 0; i < 2; ++i) { x[i][0] = (f32x4){bf_lo(v[j][i].x), bf_hi(v[j][i].x), bf_lo(v[j][i].y), bf_hi(v[j][i].y)}; x[i][1] = (f32x4){bf_lo(v[j][i].z), bf_hi(v[j][i].z), bf_lo(v[j][i].w), bf_hi(v[j][i].w)};
                ss += x[i][0][0] * x[i][0][0] + x[i][0][1] * x[i][0][1] + x[i][0][2] * x[i][0][2] + x[i][0][3] * x[i][0][3] + x[i][1][0] * x[i][1][0] + x[i][1][1] * x[i][1][1] + x[i][1][2] * x[i][1][2] + x[i][1][3] * x[i][1][3]; }
#pragma unroll
            for (int o = 32; o >= 1; o >>= 1) ss += __shfl_xor(ss, o);
            const float r = rsqrtf(ss * (1.0f / 1024.0f) + 1e-6f);
#pragma unroll
            for (int i = 0; i < 2; ++i) { float* o = out + (size_t)(row0 + 8 * j) * DM + i * 512 + lane * 8; *(f32x4*)(o) = (x[i][0] * r) * gg[i][0]; *(f32x4*)(o + 4) = (x[i][1] * r) * gg[i][1]; }
        }
    }
}

struct RetStep { size_t tok0; size_t NT; const bf16_t* vt; const bf16_t* kz; bool isctx; };
__device__ __forceinline__ RetStep ret_step(const Params& p, int step, int b, int dir) {
    RetStep r;
    r.isctx = step < 2;
    if (r.isctx) { const int ci = dir ? 1 - step : step; r.tok0 = (size_t)b * 256 + ci * 128; r.NT = MC; r.vt = (const bf16_t*)(p.ws + OFF_VTC); r.kz = (const bf16_t*)(p.ws + OFF_KTZC); }
    else { const int s = step - 2; const int ci = dir ? 15 - s : s; r.tok0 = (size_t)b * 2048 + ci * 128; r.NT = MX; r.vt = (const bf16_t*)(p.ws + OFF_VT); r.kz = (const bf16_t*)(p.ws + OFF_KTZ); }
    return r;
}
__device__ __forceinline__ void retention_item(LAS unsigned char* lds, const Params& p, int item) {
    int tid_ = threadIdx.x; asm volatile("" : "+v"(tid_));
    const int tid = tid_, wid = __builtin_amdgcn_readfirstlane(tid >> 6), lane = tid & 63, fr = lane & 15, fq = lane >> 4;
    const int b = item >> 3, h = (item >> 1) & 3, dir = item & 1;
    const float l2g = p.ret_log_decay[dir * 4 + h] * 1.4426950408889634f;
    const float decayC = exp2f(128.0f * l2g);
    LAS bf16_t* Ks = (LAS bf16_t*)lds;
    LAS bf16_t* Vts = Ks + 128 * 80;
    LAS bf16_t* Kzs = Vts + 128 * 136;
    LAS bf16_t* Sts = Kzs + 64 * 136;
    const bf16_t* P = (const bf16_t*)(p.ws + OFF_P);
    bf16_t* CAT = (bf16_t*)(p.ws + OFF_A);
    const int c = 16 * wid + fr;
    const float xi = exp2f((float)(dir ? (128 - c) : (c + 1)) * l2g);
    f32x4 accSt[4];
#pragma unroll
    for (int db = 0; db < 4; ++db) accSt[db] = (f32x4){0.f, 0.f, 0.f, 0.f};
    u32x4 pk[2], pv[4], pz[2]; bf16x8 pq[2]; u32x2 pg[8];
#pragma unroll
    for (int q = 0; q < 2; ++q) { pk[q] = (u32x4){0u, 0u, 0u, 0u}; pq[q] = __builtin_bit_cast(bf16x8, pk[q]); }
#pragma unroll
    for (int q = 0; q < 8; ++q) pg[q] = (u32x2){0u, 0u};
    {   const RetStep r = ret_step(p, 0, b, dir);
#pragma unroll
        for (int q = 0; q < 4; ++q) { const int pc = tid + q * 512, row = pc >> 4, seg = pc & 15; pv[q] = *(const u32x4*)(r.vt + (size_t)(128 * h + row) * r.NT + r.tok0 + seg * 8); }
#pragma unroll
        for (int q = 0; q < 2; ++q) { const int pc = tid + q * 512, row = pc >> 4, seg = pc & 15; pz[q] = *(const u32x4*)(r.kz + (size_t)(dir * 256 + 64 * h + row) * r.NT + r.tok0 + seg * 8); }
    }
    for (int step = 0; step < 18; ++step) {
        const RetStep cur = ret_step(p, step, b, dir);
        if (!cur.isctx) {
#pragma unroll
            for (int q = 0; q < 2; ++q) { const int pc = tid + q * 512, row = pc >> 3, seg = pc & 7; *(LAS u32x4*)(Ks + row * 80 + seg * 8) = pk[q]; }
        }
#pragma unroll
        for (int q = 0; q < 4; ++q) { const int pc = tid + q * 512, row = pc >> 4, seg = pc & 15; *(LAS u32x4*)(Vts + row * 136 + seg * 8) = pv[q]; }
#pragma unroll
        for (int q = 0; q < 2; ++q) { const int pc = tid + q * 512, row = pc >> 4, seg = pc & 15; *(LAS u32x4*)(Kzs + row * 136 + seg * 8) = pz[q]; }
        bf16x8 bq[2]; bq[0] = pq[0]; bq[1] = pq[1];
        if (step + 1 < 18) {
            const RetStep nx = ret_step(p, step + 1, b, dir);
            if (!nx.isctx) {
#pragma unroll
                for (int q = 0; q < 2; ++q) { const int pc = tid + q * 512, row = pc >> 3, seg = pc & 7; pk[q] = *(const u32x4*)(P + (nx.tok0 + row) * PW + 256 + 64 * h + seg * 8); }
                const bf16_t* qrow = P + (nx.tok0 + c) * PW + 64 * h + 8 * fq;
                pq[0] = *(const bf16x8*)(qrow); pq[1] = *(const bf16x8*)(qrow + 32);
            }
#pragma unroll
            for (int q = 0; q < 4; ++q) { const int pc = tid + q * 512, row = pc >> 4, seg = pc & 15; pv[q] = *(const u32x4*)(nx.vt + (size_t)(128 * h + row) * nx.NT + nx.tok0 + seg * 8); }
#pragma unroll
            for (int q = 0; q < 2; ++q) { const int pc = tid + q * 512, row = pc >> 4, seg = pc & 15; pz[q] = *(const u32x4*)(nx.kz + (size_t)(dir * 256 + 64 * h + row) * nx.NT + nx.tok0 + seg * 8); }
            if (step == 1) {
                const bf16_t* grow = P + (nx.tok0 + c) * PW + 512 + dir * 512 + 128 * h + 4 * fq;
#pragma unroll
                for (int eb = 0; eb < 8; ++eb) pg[eb] = *(const u32x2*)(grow + 16 * eb);
            }
        }
        __syncthreads();
        if (!cur.isctx) {
            bf16x8 qx[2];
#pragma unroll
            for (int s = 0; s < 2; ++s) { const u32x4 raw = __builtin_bit_cast(u32x4, bq[s]); u32x4 o;
                o.x = cvt_pk_bf16(bf_lo(raw.x) * xi, bf_hi(raw.x) * xi); o.y = cvt_pk_bf16(bf_lo(raw.y) * xi, bf_hi(raw.y) * xi);
                o.z = cvt_pk_bf16(bf_lo(raw.z) * xi, bf_hi(raw.z) * xi); o.w = cvt_pk_bf16(bf_lo(raw.w) * xi, bf_hi(raw.w) * xi);
                qx[s] = __builtin_bit_cast(bf16x8, o); }
            bf16x8 pf[4];
#pragma unroll
            for (int ks = 0; ks < 4; ++ks) {
                const bool live = dir ? (2 * ks + 1 >= wid) : (2 * ks <= wid);
                u32x4 o = {0u, 0u, 0u, 0u};
                if (live) {
                    f32x4 sc[2];
                    bf16x8 ka[2][2];
#pragma unroll
                    for (int q = 0; q < 2; ++q)
#pragma unroll
                        for (int s = 0; s < 2; ++s) ka[q][s] = *(const LAS bf16x8*)(Ks + (16 * (2 * ks + q) + fr) * 80 + 32 * s + 8 * fq);
                    __builtin_amdgcn_sched_barrier(0);
                    __builtin_amdgcn_s_setprio(1);
#pragma unroll
                    for (int q = 0; q < 2; ++q) { sc[q] = (f32x4){0.f, 0.f, 0.f, 0.f};
#pragma unroll
                        for (int s = 0; s < 2; ++s) sc[q] = __builtin_amdgcn_mfma_f32_16x16x32_bf16(ka[q][s], bq[s], sc[q], 0, 0, 0); }
                    __builtin_amdgcn_s_setprio(0);
#pragma unroll
                    for (int q = 0; q < 2; ++q) { const int mb = 2 * ks + q;
#pragma unroll
                        for (int r = 0; r < 4; ++r) { const int m = 16 * mb + 4 * fq + r; const int diff = dir ? (m - c) : (c - m); sc[q][r] = diff >= 0 ? sc[q][r] * __builtin_amdgcn_exp2f((float)diff * l2g) : 0.f; }
                    }
                    o.x = cvt_pk_bf16(sc[0][0], sc[0][1]); o.y = cvt_pk_bf16(sc[0][2], sc[0][3]); o.z = cvt_pk_bf16(sc[1][0], sc[1][1]); o.w = cvt_pk_bf16(sc[1][2], sc[1][3]);
                }
                pf[ks] = __builtin_bit_cast(bf16x8, o);
            }
            f32x4 accO[8];
#pragma unroll
            for (int eb = 0; eb < 8; ++eb) accO[eb] = (f32x4){0.f, 0.f, 0.f, 0.f};
#pragma unroll
            for (int s = 0; s < 2; ++s) {
                bf16x8 sa[8];
#pragma unroll
                for (int eb = 0; eb < 8; ++eb) sa[eb] = *(const LAS bf16x8*)(Sts + (16 * eb + fr) * 80 + 32 * s + 8 * fq);
                __builtin_amdgcn_sched_barrier(0);
                __builtin_amdgcn_s_setprio(1);
#pragma unroll
                for (int eb = 0; eb < 8; ++eb) accO[eb] = __builtin_amdgcn_mfma_f32_16x16x32_bf16(sa[eb], qx[s], accO[eb], 0, 0, 0);
                __builtin_amdgcn_s_setprio(0);
                __builtin_amdgcn_sched_barrier(0);
            }
#pragma unroll
            for (int ks = 0; ks < 4; ++ks) {
                const bool live = dir ? (2 * ks + 1 >= wid) : (2 * ks <= wid);
                if (live) {
                    u32x4 va[8];
#pragma unroll
                    for (int eb = 0; eb < 8; ++eb) {
                        const u32x2 lo = *(const LAS u32x2*)(Vts + (16 * eb + fr) * 136 + 32 * ks + 4 * fq), hi = *(const LAS u32x2*)(Vts + (16 * eb + fr) * 136 + 32 * ks + 16 + 4 * fq);
                        va[eb] = (u32x4){lo.x, lo.y, hi.x, hi.y};
                    }
                    __builtin_amdgcn_sched_barrier(0);
                    __builtin_amdgcn_s_setprio(1);
#pragma unroll
                    for (int eb = 0; eb < 8; ++eb) accO[eb] = __builtin_amdgcn_mfma_f32_16x16x32_bf16(__builtin_bit_cast(bf16x8, va[eb]), pf[ks], accO[eb], 0, 0, 0);
                    __builtin_amdgcn_s_setprio(0);
                    __builtin_amdgcn_sched_barrier(0);
                }
            }
            float sm = 0.f;
#pragma unroll
            for (int eb = 0; eb < 8; ++eb) sm += (accO[eb][0] + accO[eb][1]) + (accO[eb][2] + accO[eb][3]);
            sm += __shfl_xor(sm, 16); sm += __shfl_xor(sm, 32);
            const float mean = sm * (1.0f / 128.0f);
            float vq = 0.f;
#pragma unroll
            for (int eb = 0; eb < 8; ++eb) { const f32x4 d = accO[eb] - mean; vq += (d[0] * d[0] + d[1] * d[1]) + (d[2] * d[2] + d[3] * d[3]); }
            vq += __shfl_xor(vq, 16); vq += __shfl_xor(vq, 32);
            const float rstd = rsqrtf(vq * (1.0f / 128.0f) + 1e-6f);
            bf16_t* yrow = CAT + (cur.tok0 + c) * CATW + dir * 512 + 128 * h + 4 * fq;
#pragma unroll
            for (int eb = 0; eb < 8; ++eb) {
                const u32x2 gr = pg[eb];
                const f32x4 y = (accO[eb] - mean) * rstd;
                u32x2 w; w.x = cvt_pk_bf16(bf_lo(gr.x) * y[0], bf_hi(gr.x) * y[1]); w.y = cvt_pk_bf16(bf_lo(gr.y) * y[2], bf_hi(gr.y) * y[3]);
                *(u32x2*)(yrow + 16 * eb) = w;
            }
            if (step + 1 < 18) {
                const RetStep nx = ret_step(p, step + 1, b, dir);
                const bf16_t* grow = P + (nx.tok0 + c) * PW + 512 + dir * 512 + 128 * h + 4 * fq;
#pragma unroll
                for (int eb = 0; eb < 8; ++eb) pg[eb] = *(const u32x2*)(grow + 16 * eb);
            }
        }
#pragma unroll
        for (int db = 0; db < 4; ++db) accSt[db] = accSt[db] * decayC;
#pragma unroll
        for (int kh = 0; kh < 2; ++kh) {
            bf16x8 a[2], bb[2][4];
#pragma unroll
            for (int q = 0; q < 2; ++q) { const int ks = 2 * kh + q; a[q] = *(const LAS bf16x8*)(Vts + (16 * wid + fr) * 136 + 32 * ks + 8 * fq);
#pragma unroll
                for (int db = 0; db < 4; ++db) bb[q][db] = *(const LAS bf16x8*)(Kzs + (16 * db + fr) * 136 + 32 * ks + 8 * fq); }
            __builtin_amdgcn_sched_barrier(0);
            __builtin_amdgcn_s_setprio(1);
#pragma unroll
            for (int q = 0; q < 2; ++q)
#pragma unroll
                for (int db = 0; db < 4; ++db) accSt[db] = __builtin_amdgcn_mfma_f32_16x16x32_bf16(a[q], bb[q][db], accSt[db], 0, 0, 0);
            __builtin_amdgcn_s_setprio(0);
            __builtin_amdgcn_sched_barrier(0);
        }
        __syncthreads();
#pragma unroll
        for (int db = 0; db < 4; ++db)
#pragma unroll
            for (int r = 0; r < 4; ++r) Sts[(16 * wid + 4 * fq + r) * 80 + 16 * db + fr] = (bf16_t)(cvt_pk_bf16(accSt[db][r], 0.f) & 0xffffu);
    }
    __syncthreads();
}

#define XB_TMO      128
#define XB_XCNT(j)  (256  + 64 * (j))
#define XB_XSUB(j)  (1280 + 64 * (j))
#define XB_XGEN(j)  (2304 + 64 * (j))
#define XB_TOP      3328
#define XB_TOPGEN   3392
#define XCD_BAR_WORDS 3456
#define XB_SPIN_CAP (1u << 18)
__device__ __forceinline__ unsigned xb_ld(unsigned* p)              { return __hip_atomic_load(p, __ATOMIC_RELAXED, __HIP_MEMORY_SCOPE_AGENT); }
__device__ __forceinline__ unsigned xb_add(unsigned* p, unsigned v) { return __hip_atomic_fetch_add(p, v, __ATOMIC_RELAXED, __HIP_MEMORY_SCOPE_AGENT); }
__device__ __forceinline__ unsigned xb_xcc_id() { return (unsigned)__builtin_amdgcn_s_getreg((3 << 11) | 20) & 0xFu; }
#define XB_SPIN(cond, bar) do { unsigned _sp = 0; while (cond) { __builtin_amdgcn_s_sleep(1); \
    if ((++_sp & 255u) == 0u) { if (xb_ld(&(bar)[XB_TMO])) break; if (_sp > XB_SPIN_CAP) { atomicAdd(&(bar)[XB_TMO], 1u); break; } } } } while (0)
struct XcdBarrier { unsigned* bar; unsigned x; volatile LAS unsigned* st; };
__device__ __forceinline__ XcdBarrier xcd_barrier_post(unsigned* bar, volatile LAS unsigned* st) {
    XcdBarrier b; b.bar = bar; b.x = xb_xcc_id(); b.st = st;
    if (threadIdx.x == 0) (void)xb_add(&bar[XB_XCNT(b.x)], 1u);
    return b;
}
__device__ __forceinline__ void xcd_barrier_complete(unsigned* bar, unsigned x, unsigned& nloc, unsigned& nx) {
    const unsigned G = gridDim.x * gridDim.y * gridDim.z;
    unsigned sum, cnt, mine, sp = 0u;
    for (;;) {
        sum = 0u; cnt = 0u; mine = 0u;
#pragma unroll
        for (unsigned j = 0; j < 16; ++j) { const unsigned c = xb_ld(&bar[XB_XCNT(j)]); sum += c; cnt += (c > 0u) ? 1u : 0u; mine = (j == x) ? c : mine; }
        if (sum == G) break;
        __builtin_amdgcn_s_sleep(1);
        if ((++sp & 255u) == 0u) { if (xb_ld(&bar[XB_TMO])) break; if (sp > XB_SPIN_CAP) { atomicAdd(&bar[XB_TMO], 1u); break; } }
    }
    nloc = mine > 0u ? mine : 1u; nx = cnt > 0u ? cnt : 1u;
}
__device__ __forceinline__ void xcd_barrier(const XcdBarrier& b) {
    asm volatile("s_waitcnt vmcnt(0)" ::: "memory");
    __syncthreads();
    if (threadIdx.x == 0) {
        unsigned* bar = b.bar;
        __builtin_amdgcn_s_waitcnt(0);
        unsigned nloc = b.st[0], nx = b.st[1];
        if (nloc == 0u) { xcd_barrier_complete(bar, b.x, nloc, nx); b.st[0] = nloc; b.st[1] = nx; }
        const unsigned old = xb_add(&bar[XB_XSUB(b.x)], 1u);
        const unsigned gen = old / nloc;
        if (old + 1u == (gen + 1u) * nloc) {
            __builtin_amdgcn_fence(__ATOMIC_RELEASE, "agent");
            asm volatile("s_waitcnt vmcnt(0)" ::: "memory");
            const unsigned og = xb_add(&bar[XB_TOP], 1u);
            const unsigned tg = og / nx;
            if (og + 1u == (tg + 1u) * nx) xb_add(&bar[XB_TOPGEN], 1u);
            else XB_SPIN(xb_ld(&bar[XB_TOPGEN]) == tg, bar);
            __builtin_amdgcn_fence(__ATOMIC_ACQUIRE, "agent");
            xb_add(&bar[XB_XGEN(b.x)], 1u);
            asm volatile("s_waitcnt vmcnt(0)" ::: "memory");
        } else {
            XB_SPIN(xb_ld(&bar[XB_XGEN(b.x)]) == gen, bar);
            __builtin_amdgcn_fence(__ATOMIC_ACQUIRE, "agent");
            asm volatile("s_waitcnt vmcnt(0)" ::: "memory");
        }
    }
    __syncthreads();
}

#define GRID_SYNC() do { asm volatile("s_waitcnt vmcnt(0)" ::: "memory"); __syncthreads(); cg::this_grid().sync(); } while (0)
__global__ void __launch_bounds__(512, 2) fwd_megakernel(Params p) {
    extern __shared__ __attribute__((aligned(16))) unsigned char shm[];
    LAS unsigned char* lds = (LAS unsigned char*)shm;
    unsigned char* ws = p.ws;
    const float* mod = (const float*)(ws + OFF_MOD);
    bf16_t* Abuf = (bf16_t*)(ws + OFF_A);
    bf16_t* Hbuf = (bf16_t*)(ws + OFF_H);
    float* hc = (float*)(ws + OFF_HC);

    unsigned* barw = (unsigned*)(ws + OFF_BAR);
    if (blockIdx.x == 0) for (int i = threadIdx.x; i < XCD_BAR_WORDS; i += 512) barw[i] = 0u;
    volatile LAS unsigned* bst = (volatile LAS unsigned*)(lds + 131072);
    if (threadIdx.x < 4) bst[threadIdx.x] = 0u;
    phase_prep(shm, p, 0, (int)blockIdx.x, (int)gridDim.x);
    GRID_SYNC();
    const XcdBarrier xb = xcd_barrier_post(barw, bst);
    phase_norm_mod<8>(p.x, p.ctx, MT, p.norm_ffn1, mod, 0 * DM, 1 * DM, Abuf);
    xcd_barrier(xb);
    { EpiSwiGLU e; e.H = Hbuf; run_gemm(lds, Abuf, (const bf16_t*)(ws + OFF_WB13_1), MT, 5632, 1024, e); }
    xcd_barrier(xb);
    bf16_t* h1b = (bf16_t*)p.out;
    { EpiResidBfC e; e.res_x = p.x; e.res_c = p.ctx; e.hb = h1b; e.gate = mod + 2 * DM; e.gs = 0.5f; run_gemm(lds, Hbuf, (const bf16_t*)(ws + OFF_WB2_1), MT, 1024, DFF, e, 0, 1); }
    { const int rem = (int)((MT / 256 * 4) % gridDim.x);
      if (rem == 0) phase_prep(shm, p, 1, (int)blockIdx.x, (int)gridDim.x);
      else if ((int)blockIdx.x >= rem) phase_prep(shm, p, 1, (int)blockIdx.x - rem, (int)gridDim.x - rem); }
    xcd_barrier(xb);
    phase_norm_mix_pairs_bf(h1b, p.norm_mix, mod, 3 * DM, 4 * DM, Abuf, (bf16_t*)(ws + OFF_A2E), (bf16_t*)(ws + OFF_A2O));
    phase_norm_mod_bf<4>(h1b, MT, p.norm_mix, mod, 3 * DM, 4 * DM, Abuf, MX);
    xcd_barrier(xb);
    phase_ych(Abuf, (const bf16_t*)(ws + OFF_WSW) + (size_t)768 * 1024, (float*)(ws + OFF_YCH));
    { EpiInProj e; e.P = (bf16_t*)(ws + OFF_P); e.ropeA = (const float*)(ws + OFF_ROPE); e.KTZ = (bf16_t*)(ws + OFF_KTZ); e.lgd = p.ret_log_decay; run_gemm(lds, Abuf, (const bf16_t*)(ws + OFF_WBIN), MX, 1536, 1024, e); }
    { EpiSwapVF e; e.VT = (bf16_t*)(ws + OFF_VT); e.NT = MX;
      run_gemm(lds, (const bf16_t*)(ws + OFF_WSW) + (size_t)256 * 1024, Abuf, 512, MX, 1024, e); }
    { EpiSwapF e; e.YT = (bf16_t*)(ws + OFF_YT); e.part = 0;
      run_gemm(lds, (const bf16_t*)(ws + OFF_WSW) + (size_t)768 * 1024, (const bf16_t*)(ws + OFF_A2E), 512, 32768, 1024, e); }
    { EpiSwapF e; e.YT = (bf16_t*)(ws + OFF_YT); e.part = 1;
      run_gemm(lds, (const bf16_t*)(ws + OFF_WSW) + (size_t)1280 * 1024, (const bf16_t*)(ws + OFF_A2O), 512, 32768, 1024, e); }
    { EpiSwapK<false> e; e.KTZ = (bf16_t*)(ws + OFF_KTZC); e.ropeA = (const float*)(ws + OFF_ROPE); e.lgd = p.ret_log_decay; e.NT = MC;
      run_gemm(lds, (const bf16_t*)(ws + OFF_WSW), Abuf + (size_t)MX * DM, 256, MC, 1024, e, 256 - 32); }
    { EpiSwapVF e; e.VT = (bf16_t*)(ws + OFF_VTC); e.NT = MC;
      run_gemm(lds, (const bf16_t*)(ws + OFF_WSW) + (size_t)256 * 1024, Abuf + (size_t)MX * DM, 512, MC, 1024, e, 256 - 96); }
    xcd_barrier(xb);
    for (int item = blockIdx.x; item < 256; item += gridDim.x) retention_item(lds, p, item);
    { EpiFour e; e.CAT = Abuf; e.YCH = (const float*)(ws + OFF_YCH); run_gemm(lds, (const bf16_t*)(ws + OFF_TT), (const bf16_t*)(ws + OFF_YT), 2048, 16384, 2048, e); }
    xcd_barrier(xb);
    { EpiResidBfBf e; e.res_b = h1b; e.hb = (bf16_t*)(ws + OFF_H2B); e.gate = mod + 5 * DM; e.gs = 1.0f; run_gemm(lds, Abuf, (const bf16_t*)(ws + OFF_WOUT3), MX, 1024, 1536, e); }
    xcd_barrier(xb);
    phase_norm_mod_bf<8>((const bf16_t*)(ws + OFF_H2B), MX, p.norm_ffn2, mod, 6 * DM, 7 * DM, Abuf);
    xcd_barrier(xb);
    { EpiSwiGLU e; e.H = Hbuf; run_gemm(lds, Abuf, (const bf16_t*)(ws + OFF_WB13_2), MX, 5632, 1024, e); }
    xcd_barrier(xb);
    { EpiResidBfBf e; e.res_b = (const bf16_t*)(ws + OFF_H2B); e.hb = Abuf; e.gate = mod + 8 * DM; e.gs = 0.5f; run_gemm(lds, Hbuf, (const bf16_t*)(ws + OFF_WB2_2), MX, 1024, DFF, e, 0, 1); }
    xcd_barrier(xb);
    phase_final_norm(Abuf, p.out, p.norm_final);
}

extern "C" void kernel_launch(void* const* d_in, const int* in_sizes, int n_in, void* d_out, int out_size, void* d_ws, size_t ws_size, hipStream_t stream) {
    static int grid_blocks = 0;
    if (grid_blocks == 0) {
        if (n_in != 17 || ws_size < WS_END) { fprintf(stderr, "kernel_launch: unexpected n_in %d or ws_size %zu (< %zu)\n", n_in, ws_size, (size_t)WS_END); grid_blocks = -1; return; }
        int dev = 0, cus = 0, per_cu = 0;
        hipGetDevice(&dev);
        hipDeviceGetAttribute(&cus, hipDeviceAttributeMultiprocessorCount, dev);
        hipFuncSetAttribute((const void*)fwd_megakernel, hipFuncAttributeMaxDynamicSharedMemorySize, LDS_BYTES);
        hipOccupancyMaxActiveBlocksPerMultiprocessor(&per_cu, (const void*)fwd_megakernel, 512, LDS_BYTES);
        if (per_cu < 1) per_cu = 1;
        grid_blocks = cus * per_cu;
        fprintf(stderr, "kernel_launch: cus %d per_cu %d grid %d ws %zu need %zu\n", cus, per_cu, grid_blocks, ws_size, (size_t)WS_END);
    }
    if (grid_blocks < 0) return;
    Params p{};
    p.x = (const float*)d_in[0]; p.c = (const float*)d_in[1]; p.ctx = (const float*)d_in[2]; p.c_ctx = (const float*)d_in[3];
    p.w_mod = (const float*)d_in[4]; p.b_mod = (const float*)d_in[5]; p.norm_ffn1 = (const float*)d_in[6]; p.w13_1 = (const float*)d_in[7]; p.w2_1 = (const float*)d_in[8];
    p.norm_mix = (const float*)d_in[9]; p.w_in = (const float*)d_in[10]; p.ret_log_decay = (const float*)d_in[11]; p.w_out = (const float*)d_in[12];
    p.norm_ffn2 = (const float*)d_in[13]; p.w13_2 = (const float*)d_in[14]; p.w2_2 = (const float*)d_in[15]; p.norm_final = (const float*)d_in[16];
    p.out = (float*)d_out; p.ws = (unsigned char*)d_ws;
    void* args[] = {&p};
    hipError_t e = hipLaunchCooperativeKernel((const void*)fwd_megakernel, dim3(grid_blocks), dim3(512), args, LDS_BYTES, stream);
    if (e != hipSuccess) fprintf(stderr, "cooperative launch failed: %s (grid %d)\n", hipGetErrorString(e), grid_blocks);
}
```

```cpp
#include <hip/hip_runtime.h>
#include <hip/hip_cooperative_groups.h>
#include <cstdio>
namespace cg = cooperative_groups;

#define LAS __attribute__((address_space(3)))
typedef unsigned short bf16_t;
typedef short bf16x8 __attribute__((ext_vector_type(8)));
typedef short bf16x4 __attribute__((ext_vector_type(4)));
typedef float f32x4 __attribute__((ext_vector_type(4)));
typedef unsigned u32x4 __attribute__((ext_vector_type(4)));
typedef unsigned u32x2 __attribute__((ext_vector_type(2)));

constexpr int MX = 65536, MC = 8192, MT = MX + MC, DM = 1024, DFF = 2816, NMOD = 9216;
constexpr int PW = 1536;
constexpr int CATW = 1536;

constexpr size_t SZ_WB13 = (size_t)5632 * 1024 * 2, SZ_WB2 = (size_t)1024 * 2816 * 2;
constexpr size_t OFF_WB13_1 = 0;
constexpr size_t OFF_WB2_1 = OFF_WB13_1 + SZ_WB13;
constexpr size_t OFF_WB13_2 = OFF_WB2_1 + SZ_WB2;
constexpr size_t OFF_WB2_2 = OFF_WB13_2 + SZ_WB13;
constexpr size_t OFF_WBIN = OFF_WB2_2 + SZ_WB2;
constexpr size_t OFF_WSW = OFF_WBIN + (size_t)1536 * 1024 * 2;
constexpr size_t OFF_WOUT3 = OFF_WSW + (size_t)1792 * 1024 * 2;
constexpr size_t OFF_TT = OFF_WOUT3 + (size_t)1024 * 1536 * 2;
constexpr size_t OFF_MOD = OFF_TT + (size_t)2048 * 2048 * 2;
constexpr size_t OFF_ROPE = OFF_MOD + (size_t)33 * 9216 * 4;
constexpr size_t OFF_YCH = OFF_ROPE + 16384;
constexpr size_t OFF_BAR = OFF_YCH + 65536;
constexpr size_t OFF_A = (size_t)80 << 20;
constexpr size_t SZ_A = (size_t)MX * CATW * 2;
constexpr size_t OFF_H = OFF_A + SZ_A;
constexpr size_t SZ_H = (size_t)MT * DFF * 2;
constexpr size_t OFF_P = OFF_H;
constexpr size_t OFF_YT = OFF_P + (size_t)MX * PW * 2;
constexpr size_t OFF_A2E = OFF_YT + (size_t)16384 * 2048 * 2;
constexpr size_t OFF_A2O = OFF_A2E + (size_t)32768 * 1024 * 2;
constexpr size_t OFF_HC = OFF_H + SZ_H;
constexpr size_t OFF_KTZ = OFF_HC + (size_t)MC * DM * 4;
constexpr size_t OFF_VT = OFF_KTZ + (size_t)2 * 256 * MX * 2;
constexpr size_t OFF_KTZC = OFF_VT + (size_t)512 * MX * 2;
constexpr size_t OFF_VTC = OFF_KTZC + (size_t)2 * 256 * MC * 2;
constexpr size_t OFF_H2B = OFF_KTZ;
constexpr size_t WS_END = OFF_VTC + (size_t)512 * MC * 2;
static_assert(OFF_BAR + 3456 * 4 <= OFF_A, "weights region overflow");
static_assert(OFF_A2O + (size_t)32768 * 1024 * 2 <= OFF_HC, "mix buffers overflow H region");

constexpr int XCD_BAR_WORDS_C = 3456;
constexpr int LDS_BYTES = 131072 + 16;

struct Params {
    const float *x, *c, *ctx, *c_ctx, *w_mod, *b_mod, *norm_ffn1, *w13_1, *w2_1, *norm_mix, *w_in, *ret_log_decay, *w_out, *norm_ffn2, *w13_2, *w2_2, *norm_final;
    float* out; unsigned char* ws;
};

__device__ __forceinline__ unsigned cvt_pk_bf16(float lo, float hi) { unsigned r; asm volatile("v_cvt_pk_bf16_f32 %0, %1, %2" : "=v"(r) : "v"(lo), "v"(hi)); return r; }
__device__ __forceinline__ float bf_lo(unsigned u) { return __uint_as_float(u << 16); }
__device__ __forceinline__ float bf_hi(unsigned u) { return __uint_as_float(u & 0xffff0000u); }
__device__ __forceinline__ float silu_f(float a) { return a * __builtin_amdgcn_rcpf(1.0f + __expf(-a)); }

typedef float f32x2 __attribute__((ext_vector_type(2)));
__device__ __forceinline__ f32x2 silu_mul_pk(f32x2 a, f32x2 b) {
    const f32x2 t = a * (-1.4426950408889634f);
    f32x2 e; e.x = __builtin_amdgcn_exp2f(t.x); e.y = __builtin_amdgcn_exp2f(t.y);
    const f32x2 d = e + 1.0f;
    f32x2 r; r.x = __builtin_amdgcn_rcpf(d.x); r.y = __builtin_amdgcn_rcpf(d.y);
    return (a * b) * r;
}

namespace pg8 {
constexpr int BM = 256, BK = 64, HALF = 128, HTB = HALF * BK * 2, STAGE_BYTES = 8 * HTB, NXCD = 8, WGM = 8;
__device__ __forceinline__ int lds_byte(int r, int c) { const int st = (r >> 4) * 2 + (c >> 5), rr = r & 15, cc = c & 31, ob = rr * 64 + cc * 2; return st * 1024 + (ob ^ (((ob >> 9) & 1) << 5)); }
__device__ __forceinline__ void stage_rc(int b, int& R, int& C) { const int st = b / 1024, sb = b % 1024, swz = sb ^ (((sb >> 9) & 1) << 5); R = (st >> 1) * 16 + swz / 64; C = (st & 1) * 32 + (swz % 64) / 2; }
__device__ __forceinline__ int perm32(int rho) { const int n = rho >> 4, i = rho & 15; return 8 * (i >> 2) + 4 * n + (i & 3); }
struct Unit { int pm, pn; };
struct Gemm { const bf16_t* A; const bf16_t* Bt; int M, N, K; };
struct StaticOrder {
    int nM, nN, nwg, G, c, rev;
    __device__ void init(int M, int N, int G_, int c_, int rev_ = 0) { nM = M / BM; nN = N / BM; nwg = nM * nN; G = G_; c = c_; rev = rev_; }
    __device__ bool next(int i, Unit& u) const {
        const long L = (long)i * G + c; if (L >= nwg) return false;
        int wgid = rev ? (int)(nwg - 1 - L) : (int)L; { const int q = nwg / NXCD, r = nwg % NXCD, xcd = wgid % NXCD, off = wgid / NXCD; wgid = (xcd < r ? xcd * (q + 1) : r * (q + 1) + (xcd - r) * q) + off; }
        const int nig = WGM * nN, gid = wgid / nig, fm = gid * WGM, gsz = (nM - fm) < WGM ? (nM - fm) : WGM;
        u.pm = fm + ((wgid % nig) % gsz); u.pn = (wgid % nig) / gsz; return true;
    }
};

template <class Epi, class Sched>
__device__ __forceinline__ void gemm_phase(LAS unsigned char* lds, const Gemm g, const Sched& S, const Epi& E) {
    int tid_ = threadIdx.x; asm volatile("" : "+v"(tid_));
    const int tid = tid_, wid = __builtin_amdgcn_readfirstlane(tid >> 6), lane = tid & 63, wr = wid >> 2, wc = wid & 3, fr = lane & 15, fq = lane >> 4;
    const int K = g.K, nt = K / BK;
    unsigned voffA[2], voffB[2];
#pragma unroll
    for (int i = 0; i < 2; ++i) { int R, C; stage_rc(tid * 16 + i * 8192, R, C); const int Rb = Epi::PERM ? ((R & ~31) + perm32(R & 31)) : R;
        voffA[i] = (unsigned)(R * K + C) * 2u; voffB[i] = (unsigned)(Rb * K + C) * 2u; }
    const size_t kstep = (size_t)(BK * 2);
    const size_t hstep = (size_t)HALF * K * 2;
    const size_t tstep = 2 * hstep;
    const unsigned ldsw = (unsigned)wid * 1024u;
    const int aoff = lds_byte(wr * 64 + fr, fq * 8), boff = lds_byte(wc * 32 + fr, fq * 8);
#define PG8_SA(b, h) (((b) * 2 + (h)) * HTB)
#define PG8_SB(b, h) ((4 + (b) * 2 + (h)) * HTB)
#define PG8_STAGE(bufoff, gbase, voff) do { _Pragma("unroll") for (int _i = 0; _i < 2; ++_i) \
        __builtin_amdgcn_global_load_lds((const unsigned*)((const char*)(gbase) + (voff)[_i]), (LAS unsigned*)(lds + (bufoff) + ldsw + _i * 8192), 16, 0, 0); } while (0)
#define PG8_LDA(dst, b, h) do { _Pragma("unroll") for (int m = 0; m < 4; ++m) _Pragma("unroll") for (int k = 0; k < 2; ++k) dst[m][k] = *(const LAS bf16x8*)(lds + PG8_SA(b, h) + aoff + m * 2048 + k * 1024); } while (0)
#define PG8_LDB(dst, b, h) do { _Pragma("unroll") for (int n = 0; n < 2; ++n) _Pragma("unroll") for (int k = 0; k < 2; ++k) dst[n][k] = *(const LAS bf16x8*)(lds + PG8_SB(b, h) + boff + n * 2048 + k * 1024); } while (0)
#define PG8_MMA(ai, bj, At, Bt) do { __builtin_amdgcn_s_setprio(1); _Pragma("unroll") for (int m = 0; m < 4; ++m) _Pragma("unroll") for (int n = 0; n < 2; ++n) _Pragma("unroll") for (int k = 0; k < 2; ++k) \
        acc[ai][bj][m][n] = __builtin_amdgcn_mfma_f32_16x16x32_bf16(Bt[n][k], At[m][k], acc[ai][bj][m][n], 0, 0, 0); __builtin_amdgcn_s_setprio(0); } while (0)
#define PG8_WAIT_V(n) asm volatile("s_waitcnt vmcnt(" #n ")" ::: "memory")
#define PG8_WAIT_L(n) asm volatile("s_waitcnt lgkmcnt(" #n ")" ::: "memory")
#define PG8_BAR __builtin_amdgcn_s_barrier()
#define PG8_SCHED __builtin_amdgcn_sched_barrier(0)
    Unit cur, nxt; int ui = 0;
    if (!S.next(0, cur)) return;
    f32x4 acc[2][2][4][2];
#pragma unroll
    for (int a = 0; a < 2; ++a)
#pragma unroll
        for (int b = 0; b < 2; ++b)
#pragma unroll
            for (int m = 0; m < 4; ++m)
#pragma unroll
                for (int n = 0; n < 2; ++n) acc[a][b][m][n] = (f32x4){0.f, 0.f, 0.f, 0.f};
    bf16x8 At[4][2], B0[2][2], B1[2][2];
    const char* cA = (const char*)g.A + (size_t)cur.pm * tstep; const char* cB = (const char*)g.Bt + (size_t)cur.pn * tstep;
    PG8_STAGE(PG8_SB(0, 0), cB, voffB); PG8_STAGE(PG8_SA(0, 0), cA, voffA); PG8_STAGE(PG8_SB(0, 1), cB + hstep, voffB); PG8_STAGE(PG8_SA(0, 1), cA + hstep, voffA);
    if (wr == 1) PG8_BAR;
    PG8_WAIT_V(4); PG8_BAR;
    PG8_STAGE(PG8_SB(1, 0), cB + kstep, voffB); PG8_STAGE(PG8_SA(1, 0), cA + kstep, voffA); PG8_STAGE(PG8_SB(1, 1), cB + hstep + kstep, voffB);
    PG8_WAIT_V(6); PG8_BAR;
    for (;;) {
        const bool has_next = S.next(ui + 1, nxt);
        const char* nA = has_next ? (const char*)g.A + (size_t)nxt.pm * tstep : cA; const char* nB = has_next ? (const char*)g.Bt + (size_t)nxt.pn * tstep : cB;
        for (int t = 0; t < nt; t += 2) {
            const bool last = (t == nt - 2);
            const char* a1 = cA + (size_t)(t + 1) * kstep;
            const char* a2 = last ? nA : cA + (size_t)(t + 2) * kstep; const char* b2 = last ? nB : cB + (size_t)(t + 2) * kstep;
            const char* a3 = a2 + kstep; const char* b3 = b2 + kstep;
            PG8_LDB(B0, 0, 0); PG8_SCHED; PG8_LDA(At, 0, 0); PG8_STAGE(PG8_SA(1, 1), a1 + hstep, voffA);
            PG8_WAIT_L(8); PG8_BAR; PG8_WAIT_L(0); PG8_MMA(0, 0, At, B0); PG8_BAR; PG8_SCHED;
            PG8_LDB(B1, 0, 1); PG8_STAGE(PG8_SB(0, 0), b2, voffB);
            PG8_BAR; PG8_WAIT_L(0); PG8_MMA(0, 1, At, B1); PG8_BAR;
            PG8_LDA(At, 0, 1); PG8_STAGE(PG8_SA(0, 0), a2, voffA);
            PG8_BAR; PG8_WAIT_L(0); PG8_MMA(1, 0, At, B0); PG8_BAR; PG8_SCHED;
            PG8_STAGE(PG8_SB(0, 1), b2 + hstep, voffB);
            PG8_WAIT_V(6); PG8_BAR; PG8_MMA(1, 1, At, B1); PG8_BAR;
            PG8_LDB(B0, 1, 0); PG8_SCHED; PG8_LDA(At, 1, 0); PG8_STAGE(PG8_SA(0, 1), a2 + hstep, voffA);
            PG8_WAIT_L(8); PG8_BAR; PG8_WAIT_L(0); PG8_MMA(0, 0, At, B0); PG8_BAR; PG8_SCHED;
            PG8_LDB(B1, 1, 1); PG8_STAGE(PG8_SB(1, 0), b3, voffB);
            PG8_BAR; PG8_WAIT_L(0); PG8_MMA(0, 1, At, B1); PG8_BAR;
            PG8_LDA(At, 1, 1); PG8_STAGE(PG8_SA(1, 0), a3, voffA);
            PG8_BAR; PG8_WAIT_L(0); PG8_MMA(1, 0, At, B0); PG8_BAR; PG8_SCHED;
            PG8_STAGE(PG8_SB(1, 1), b3 + hstep, voffB);
            PG8_WAIT_V(6); PG8_BAR; PG8_MMA(1, 1, At, B1); PG8_BAR;
        }
        E(acc, cur, wr, wc, fr, fq);
        if (!has_next) break;
#pragma unroll
        for (int a = 0; a < 2; ++a)
#pragma unroll
            for (int b = 0; b < 2; ++b)
#pragma unroll
                for (int m = 0; m < 4; ++m)
#pragma unroll
                    for (int n = 0; n < 2; ++n) acc[a][b][m][n] = (f32x4){0.f, 0.f, 0.f, 0.f};
        cur = nxt; cA = nA; cB = nB; ++ui;
    }
    PG8_WAIT_V(0);
    if (wr == 0) PG8_BAR;
    PG8_BAR;
#undef PG8_SA
#undef PG8_SB
#undef PG8_STAGE
#undef PG8_LDA
#undef PG8_LDB
#undef PG8_MMA
#undef PG8_WAIT_V
#undef PG8_WAIT_L
#undef PG8_BAR
#undef PG8_SCHED
}
}
using pg8::Unit;
typedef f32x4 AccT[2][2][4][2];


struct EpiSwiGLU {
    static constexpr bool PERM = true;
    bf16_t* H;
    __device__ __forceinline__ void operator()(const AccT& acc, const Unit& u, int wr, int wc, int fr, int fq) const {
        asm volatile("" : "+v"(fr), "+v"(fq));
        const int row0 = u.pm * 256 + wr * 64 + fr, hc0 = u.pn * 128 + wc * 32 + 8 * fq;
#pragma unroll
        for (int ai = 0; ai < 2; ++ai)
#pragma unroll
            for (int m = 0; m < 4; ++m) {
                const f32x4 a0 = acc[ai][0][m][0], a1 = acc[ai][0][m][1], b0 = acc[ai][1][m][0], b1 = acc[ai][1][m][1];
                const f32x2 h0 = silu_mul_pk((f32x2){a0[0], a0[1]}, (f32x2){b0[0], b0[1]}), h1 = silu_mul_pk((f32x2){a0[2], a0[3]}, (f32x2){b0[2], b0[3]});
                const f32x2 h2 = silu_mul_pk((f32x2){a1[0], a1[1]}, (f32x2){b1[0], b1[1]}), h3 = silu_mul_pk((f32x2){a1[2], a1[3]}, (f32x2){b1[2], b1[3]});
                u32x4 w; w.x = cvt_pk_bf16(h0.x, h0.y); w.y = cvt_pk_bf16(h1.x, h1.y); w.z = cvt_pk_bf16(h2.x, h2.y); w.w = cvt_pk_bf16(h3.x, h3.y);
                *(u32x4*)(H + (size_t)(row0 + ai * 128 + m * 16) * DFF + hc0) = w;
            }
    }
};

struct EpiResid {
    static constexpr bool PERM = false;
    const float* res_x; const float* res_c; float* out_x; float* out_c; const float* gate; float gs;
    __device__ __forceinline__ void operator()(const AccT& acc, const Unit& u, int wr, int wc, int fr, int fq) const {
        asm volatile("" : "+v"(fr), "+v"(fq));
        const int rowt = u.pm * 256; const bool isc = rowt >= MX;
        const int b = isc ? 32 : (rowt >> 11);
        const float* res = isc ? res_c + (size_t)(rowt - MX) * DM : res_x + (size_t)rowt * DM;
        float* out = isc ? out_c + (size_t)(rowt - MX) * DM : out_x + (size_t)rowt * DM;
        const int col0 = u.pn * 256 + wc * 32 + 4 * fq;
        f32x4 gv[2][2];
#pragma unroll
        for (int bj = 0; bj < 2; ++bj)
#pragma unroll
            for (int n = 0; n < 2; ++n) gv[bj][n] = *(const f32x4*)(gate + (size_t)b * NMOD + col0 + bj * 128 + n * 16) * gs;
#pragma unroll
        for (int ai = 0; ai < 2; ++ai) {
            const size_t ro = (size_t)(wr * 64 + fr + ai * 128) * DM + col0;
            f32x4 r[4][2][2];
#pragma unroll
            for (int m = 0; m < 4; ++m)
#pragma unroll
                for (int bj = 0; bj < 2; ++bj)
#pragma unroll
                    for (int n = 0; n < 2; ++n) r[m][bj][n] = *(const f32x4*)(res + ro + (size_t)m * 16 * DM + bj * 128 + n * 16);
#pragma unroll
            for (int m = 0; m < 4; ++m)
#pragma unroll
                for (int bj = 0; bj < 2; ++bj)
#pragma unroll
                    for (int n = 0; n < 2; ++n) *(f32x4*)(out + ro + (size_t)m * 16 * DM + bj * 128 + n * 16) = r[m][bj][n] + gv[bj][n] * acc[ai][bj][m][n];
        }
    }
};

struct EpiResidBf {
    static constexpr bool PERM = true;
    const float* res_x; bf16_t* hb; const float* gate; float gs;
    __device__ __forceinline__ void operator()(const AccT& acc, const Unit& u, int wr, int wc, int fr, int fq) const {
        asm volatile("" : "+v"(fr), "+v"(fq));
        const int rowt = u.pm * 256; const int b = rowt >> 11;
        const float* res = res_x + (size_t)rowt * DM; bf16_t* out = hb + (size_t)rowt * DM;
        const int col0 = u.pn * 256 + wc * 32 + 8 * fq;
        f32x4 gv[2][2];
#pragma unroll
        for (int bj = 0; bj < 2; ++bj)
#pragma unroll
            for (int n = 0; n < 2; ++n) gv[bj][n] = *(const f32x4*)(gate + (size_t)b * NMOD + col0 + bj * 128 + n * 4) * gs;
#pragma unroll
        for (int ai = 0; ai < 2; ++ai) {
            const size_t ro = (size_t)(wr * 64 + fr + ai * 128) * DM + col0;
            f32x4 r[4][2][2];
#pragma unroll
            for (int m = 0; m < 4; ++m)
#pragma unroll
                for (int bj = 0; bj < 2; ++bj)
#pragma unroll
                    for (int n = 0; n < 2; ++n) r[m][bj][n] = *(const f32x4*)(res + ro + (size_t)m * 16 * DM + bj * 128 + n * 4);
#pragma unroll
            for (int m = 0; m < 4; ++m)
#pragma unroll
                for (int bj = 0; bj < 2; ++bj) {
                    const f32x4 h0 = r[m][bj][0] + gv[bj][0] * acc[ai][bj][m][0], h1 = r[m][bj][1] + gv[bj][1] * acc[ai][bj][m][1];
                    u32x4 w; w.x = cvt_pk_bf16(h0[0], h0[1]); w.y = cvt_pk_bf16(h0[2], h0[3]); w.z = cvt_pk_bf16(h1[0], h1[1]); w.w = cvt_pk_bf16(h1[2], h1[3]);
                    *(u32x4*)(out + ro + (size_t)m * 16 * DM + bj * 128) = w;
                }
        }
    }
};

struct EpiResidBfBf {
    static constexpr bool PERM = true;
    const bf16_t* res_b; bf16_t* hb; const float* gate; float gs;
    __device__ __forceinline__ void operator()(const AccT& acc, const Unit& u, int wr, int wc, int fr, int fq) const {
        asm volatile("" : "+v"(fr), "+v"(fq));
        const int rowt = u.pm * 256; const int b = rowt >> 11;
        const bf16_t* res = res_b + (size_t)rowt * DM; bf16_t* out = hb + (size_t)rowt * DM;
        const int col0 = u.pn * 256 + wc * 32 + 8 * fq;
        f32x4 gv[2][2];
#pragma unroll
        for (int bj = 0; bj < 2; ++bj)
#pragma unroll
            for (int n = 0; n < 2; ++n) gv[bj][n] = *(const f32x4*)(gate + (size_t)b * NMOD + col0 + bj * 128 + n * 4) * gs;
        u32x4 r[2][4][2];
#pragma unroll
        for (int ai = 0; ai < 2; ++ai)
#pragma unroll
            for (int m = 0; m < 4; ++m)
#pragma unroll
                for (int bj = 0; bj < 2; ++bj) r[ai][m][bj] = *(const u32x4*)(res + (size_t)(wr * 64 + fr + ai * 128 + m * 16) * DM + col0 + bj * 128);
#pragma unroll
        for (int ai = 0; ai < 2; ++ai)
#pragma unroll
            for (int m = 0; m < 4; ++m)
#pragma unroll
                for (int bj = 0; bj < 2; ++bj) {
                    const u32x4 q = r[ai][m][bj];
                    const f32x4 r0 = {bf_lo(q.x), bf_hi(q.x), bf_lo(q.y), bf_hi(q.y)}, r1 = {bf_lo(q.z), bf_hi(q.z), bf_lo(q.w), bf_hi(q.w)};
                    const f32x4 h0 = r0 + gv[bj][0] * acc[ai][bj][m][0], h1 = r1 + gv[bj][1] * acc[ai][bj][m][1];
                    u32x4 w; w.x = cvt_pk_bf16(h0[0], h0[1]); w.y = cvt_pk_bf16(h0[2], h0[3]); w.z = cvt_pk_bf16(h1[0], h1[1]); w.w = cvt_pk_bf16(h1[2], h1[3]);
                    *(u32x4*)(out + (size_t)(wr * 64 + fr + ai * 128 + m * 16) * DM + col0 + bj * 128) = w;
                }
    }
};

struct EpiResidBfC {
    static constexpr bool PERM = true;
    const float* res_x; const float* res_c; bf16_t* hb; const float* gate; float gs;
    __device__ __forceinline__ void operator()(const AccT& acc, const Unit& u, int wr, int wc, int fr, int fq) const {
        asm volatile("" : "+v"(fr), "+v"(fq));
        const int rowt = u.pm * 256; const bool isc = rowt >= MX; const int b = isc ? 32 : (rowt >> 11);
        const float* res = isc ? res_c + (size_t)(rowt - MX) * DM : res_x + (size_t)rowt * DM; bf16_t* out = hb + (size_t)rowt * DM;
        const int col0 = u.pn * 256 + wc * 32 + 8 * fq;
        f32x4 gv[2][2];
#pragma unroll
        for (int bj = 0; bj < 2; ++bj)
#pragma unroll
            for (int n = 0; n < 2; ++n) gv[bj][n] = *(const f32x4*)(gate + (size_t)b * NMOD + col0 + bj * 128 + n * 4) * gs;
#pragma unroll
        for (int ai = 0; ai < 2; ++ai) {
            const size_t ro = (size_t)(wr * 64 + fr + ai * 128) * DM + col0;
            f32x4 r[4][2][2];
#pragma unroll
            for (int m = 0; m < 4; ++m)
#pragma unroll
                for (int bj = 0; bj < 2; ++bj)
#pragma unroll
                    for (int n = 0; n < 2; ++n) r[m][bj][n] = *(const f32x4*)(res + ro + (size_t)m * 16 * DM + bj * 128 + n * 4);
#pragma unroll
            for (int m = 0; m < 4; ++m)
#pragma unroll
                for (int bj = 0; bj < 2; ++bj) {
                    const f32x4 h0 = r[m][bj][0] + gv[bj][0] * acc[ai][bj][m][0], h1 = r[m][bj][1] + gv[bj][1] * acc[ai][bj][m][1];
                    u32x4 w; w.x = cvt_pk_bf16(h0[0], h0[1]); w.y = cvt_pk_bf16(h0[2], h0[3]); w.z = cvt_pk_bf16(h1[0], h1[1]); w.w = cvt_pk_bf16(h1[2], h1[3]);
                    *(u32x4*)(out + ro + (size_t)m * 16 * DM + bj * 128) = w;
                }
        }
    }
};

struct EpiInProj {
    static constexpr bool PERM = true;
    bf16_t* P; const float* ropeA;
    bf16_t* KTZ; const float* lgd;
    __device__ __forceinline__ void operator()(const AccT& acc, const Unit& u, int wr, int wc, int fr, int fq) const {
        asm volatile("" : "+v"(fr), "+v"(fq));
        const int row0 = u.pm * 256 + wr * 64 + fr, col0 = u.pn * 256 + wc * 32 + 8 * fq;
        const bool rope = u.pn < 2, ktile = u.pn == 1;
        const int i = 4 * (wc & 1) + fq;
#pragma unroll
        for (int ai = 0; ai < 2; ++ai)
#pragma unroll
            for (int m = 0; m < 4; ++m) {
                const int row = row0 + ai * 128 + m * 16;
                f32x4 cs = {1.f, 1.f, 1.f, 1.f}, sn = {0.f, 0.f, 0.f, 0.f};
                if (rope) { const int t = row & 2047; const int pos = (i < 4) ? (t >> 6) : (t & 63);
                    cs = *(const f32x4*)(ropeA + pos * 16 + ((4 * i) & 15)); sn = *(const f32x4*)(ropeA + 1024 + pos * 16 + ((4 * i) & 15)); }
#pragma unroll
                for (int bj = 0; bj < 2; ++bj) {
                    const f32x4 t1 = acc[ai][bj][m][0], t2 = acc[ai][bj][m][1];
                    f32x4 o1 = t1 * cs - t2 * sn, o2 = t2 * cs + t1 * sn;
                    if (!rope) {
#pragma unroll
                        for (int jj = 0; jj < 4; ++jj) { o1[jj] = silu_f(t1[jj]); o2[jj] = silu_f(t2[jj]); }
                    }
                    u32x4 w; w.x = cvt_pk_bf16(o1[0], o1[1]); w.y = cvt_pk_bf16(o1[2], o1[3]); w.z = cvt_pk_bf16(o2[0], o2[1]); w.w = cvt_pk_bf16(o2[2], o2[3]);
                    *(u32x4*)(P + (size_t)row * PW + col0 + bj * 128) = w;
                    if (ktile) {
                        const int hh = 2 * bj + (wc >> 1), o = wr * 64 + fr + m * 16;
                        const float zf = exp2f((float)(127 - o) * (lgd[hh] * 1.4426950408889634f)), zb = exp2f((float)o * (lgd[4 + hh] * 1.4426950408889634f));
                        bf16_t* kf = KTZ + (size_t)(wc * 32 + 8 * fq + bj * 128) * MX + row; bf16_t* kb = kf + (size_t)256 * MX;
#pragma unroll
                        for (int e = 0; e < 8; ++e) { const float v = e < 4 ? o1[e & 3] : o2[e & 3]; const unsigned pk = cvt_pk_bf16(v * zf, v * zb);
                            kf[(size_t)e * MX] = (bf16_t)(pk & 0xffffu); kb[(size_t)e * MX] = (bf16_t)(pk >> 16); }
                    }
                }
            }
    }
};

template <bool ROPE> struct EpiSwapK {
    static constexpr bool PERM = true;
    bf16_t* KTZ; const float* ropeA; const float* lgd; int NT;
    __device__ __forceinline__ void operator()(const AccT& acc, const Unit& u, int wr, int wc, int fr, int fq) const {
        asm volatile("" : "+v"(fr), "+v"(fq));
        const int rbase = wr * 64 + fr;
        const int tb = u.pn * 256 + wc * 32 + 8 * fq;
        const int o0 = wc * 32 + 8 * fq;
        const int j = fr & 3; const float sgn = ((fr >> 2) & 1) ? 1.0f : -1.0f;
#pragma unroll
        for (int ai = 0; ai < 2; ++ai) {
            const int hh = 2 * ai + wr;
            const float l2f = lgd[hh] * 1.4426950408889634f, l2b = lgd[4 + hh] * 1.4426950408889634f;
            const float zf0 = exp2f((float)(127 - o0) * l2f), zfs = exp2f(-l2f), zb0 = exp2f((float)o0 * l2b), zbs = exp2f(l2b);
#pragma unroll
            for (int m = 0; m < 4; ++m) {
                const int r = rbase + ai * 128 + m * 16;
                const int d = 4 * (2 * m + (fr >> 3)) + j;
#pragma unroll
                for (int bj = 0; bj < 2; ++bj) {
                    const int t0 = tb + bj * 128;
                    float v[8];
#pragma unroll
                    for (int jj = 0; jj < 4; ++jj) { v[jj] = acc[ai][bj][m][0][jj]; v[4 + jj] = acc[ai][bj][m][1][jj]; }
                    if constexpr (ROPE) {
                        const int t = t0 & 2047;
#pragma unroll
                        for (int hf = 0; hf < 2; ++hf) {
                            f32x4 cs, sn;
                            if (m < 2) { const float c1 = ropeA[(t >> 6) * 16 + d], s1 = ropeA[1024 + (t >> 6) * 16 + d]; cs = (f32x4){c1, c1, c1, c1}; sn = (f32x4){s1, s1, s1, s1}; }
                            else { const float* cb = ropeA + 2048 + (d - 16) * 64 + (t & 63) + 4 * hf; cs = *(const f32x4*)(cb); sn = *(const f32x4*)(cb + 1024); }
#pragma unroll
                            for (int jj = 0; jj < 4; ++jj) { const float pr = __shfl_xor(v[4 * hf + jj], 4); v[4 * hf + jj] = v[4 * hf + jj] * cs[jj] + sgn * pr * sn[jj]; }
                            __builtin_amdgcn_sched_barrier(0);
                        }
                    }
                    float zf[8], zb[8]; zf[0] = zf0; zb[0] = zb0;
#pragma unroll
                    for (int jj = 1; jj < 8; ++jj) { zf[jj] = zf[jj - 1] * zfs; zb[jj] = zb[jj - 1] * zbs; }
                    u32x4 wf, wb;
                    wf.x = cvt_pk_bf16(v[0] * zf[0], v[1] * zf[1]); wf.y = cvt_pk_bf16(v[2] * zf[2], v[3] * zf[3]); wf.z = cvt_pk_bf16(v[4] * zf[4], v[5] * zf[5]); wf.w = cvt_pk_bf16(v[6] * zf[6], v[7] * zf[7]);
                    wb.x = cvt_pk_bf16(v[0] * zb[0], v[1] * zb[1]); wb.y = cvt_pk_bf16(v[2] * zb[2], v[3] * zb[3]); wb.z = cvt_pk_bf16(v[4] * zb[4], v[5] * zb[5]); wb.w = cvt_pk_bf16(v[6] * zb[6], v[7] * zb[7]);
                    *(u32x4*)(KTZ + (size_t)r * NT + t0) = wf;
                    *(u32x4*)(KTZ + (size_t)(256 + r) * NT + t0) = wb;
                    __builtin_amdgcn_sched_barrier(0);
                }
            }
        }
    }
};
struct EpiSwapVF {
    static constexpr bool PERM = true;
    bf16_t* VT; int NT;
    __device__ __forceinline__ void operator()(const AccT& acc, const Unit& u, int wr, int wc, int fr, int fq) const {
        asm volatile("" : "+v"(fr), "+v"(fq));
        const int rbase = u.pm * 256 + wr * 64 + fr;
        const int tb = u.pn * 256 + wc * 32 + 8 * fq;
#pragma unroll
        for (int ai = 0; ai < 2; ++ai)
#pragma unroll
            for (int m = 0; m < 4; ++m) {
                const int r = rbase + ai * 128 + m * 16;
#pragma unroll
                for (int bj = 0; bj < 2; ++bj) {
                    const int t0 = tb + bj * 128;
                    const f32x4 v0 = acc[ai][bj][m][0], v1 = acc[ai][bj][m][1];
                    u32x4 w; w.x = cvt_pk_bf16(v0[0], v0[1]); w.y = cvt_pk_bf16(v0[2], v0[3]); w.z = cvt_pk_bf16(v1[0], v1[1]); w.w = cvt_pk_bf16(v1[2], v1[3]);
                    *(u32x4*)(VT + (size_t)r * NT + t0) = w;
                }
            }
    }
};
struct EpiSwapF {
    static constexpr bool PERM = true;
    bf16_t* YT; int part;
    __device__ __forceinline__ void operator()(const AccT& acc, const Unit& u, int wr, int wc, int fr, int fq) const {
        asm volatile("" : "+v"(fr), "+v"(fq));
        const int rbase = u.pm * 256 + wr * 64 + fr;
        const int tb = u.pn * 256 + wc * 32 + 8 * fq;
#pragma unroll
        for (int ai = 0; ai < 2; ++ai)
#pragma unroll
            for (int m = 0; m < 4; ++m) {
                const int gm = rbase + ai * 128 + m * 16;
#pragma unroll
                for (int bj = 0; bj < 2; ++bj) {
                    const int t0 = tb + bj * 128;
                    const f32x4 v0 = acc[ai][bj][m][0], v1 = acc[ai][bj][m][1];
                    u32x4 w; w.x = cvt_pk_bf16(v0[0], v0[1]); w.y = cvt_pk_bf16(v0[2], v0[3]); w.z = cvt_pk_bf16(v1[0], v1[1]); w.w = cvt_pk_bf16(v1[2], v1[3]);
                    *(u32x4*)(YT + ((size_t)((t0 >> 10) * 512 + gm)) * 2048 + part * 1024 + (t0 & 1023)) = w;
                }
            }
    }
};

struct EpiFour {
    static constexpr bool PERM = true;
    bf16_t* CAT; const float* YCH;
    __device__ __forceinline__ void operator()(const AccT& acc, const Unit& u, int wr, int wc, int fr, int fq) const {
        asm volatile("" : "+v"(fr), "+v"(fq));
        const int row0 = u.pm * 256 + wr * 64 + fr; const int b = u.pn >> 1, ch0 = (u.pn & 1) * 256 + wc * 32 + 8 * fq;
        const float sg = (fr & 1) ? -1.0f : 1.0f;
        f32x4 yh[2][2];
#pragma unroll
        for (int bj = 0; bj < 2; ++bj)
#pragma unroll
            for (int n = 0; n < 2; ++n) yh[bj][n] = *(const f32x4*)(YCH + b * 512 + ch0 + bj * 128 + 4 * n) * sg;
#pragma unroll
        for (int ai = 0; ai < 2; ++ai)
#pragma unroll
            for (int m = 0; m < 4; ++m) {
                const int k = row0 + ai * 128 + m * 16;
#pragma unroll
                for (int bj = 0; bj < 2; ++bj) {
                    const f32x4 v0 = acc[ai][bj][m][0] + yh[bj][0], v1 = acc[ai][bj][m][1] + yh[bj][1];
                    u32x4 w; w.x = cvt_pk_bf16(v0[0], v0[1]); w.y = cvt_pk_bf16(v0[2], v0[3]); w.z = cvt_pk_bf16(v1[0], v1[1]); w.w = cvt_pk_bf16(v1[2], v1[3]);
                    *(u32x4*)(CAT + (size_t)(b * 2048 + k) * CATW + 1024 + ch0 + bj * 128) = w;
                }
            }
    }
};

template <class Epi>
__device__ __forceinline__ void run_gemm(LAS unsigned char* lds, const bf16_t* A, const bf16_t* Bt, int M, int N, int K, const Epi& E, int rot = 0, int rev = 0) {
    pg8::Gemm g; g.A = A; g.Bt = Bt; g.M = M; g.N = N; g.K = K;
    pg8::StaticOrder S; S.init(M, N, (int)gridDim.x, (int)((blockIdx.x + rot) % gridDim.x), rev);
    pg8::gemm_phase<Epi, pg8::StaticOrder>(lds, g, S, E);
}

__device__ __forceinline__ void prep_tile(unsigned char* shm, const float* src, int sld, int srow0, int scol0, bf16_t* dst, int dld, int r0, int k0, bool perm, float scale) {
    float* tile = (float*)shm;
    const int t = threadIdx.x, tx = t & 127, ty = t >> 7;
    __syncthreads();
    float ld[16];
#pragma unroll
    for (int q = 0; q < 16; ++q) ld[q] = src[(size_t)(srow0 + ty + 4 * q) * sld + scol0 + tx];
#pragma unroll
    for (int q = 0; q < 16; ++q) tile[(ty + 4 * q) * 129 + tx] = ld[q];
    __syncthreads();
    const int rr = t >> 2, ks = (t & 3) * 16;
    const int r6 = rr & 63;
    const int sc = perm ? ((rr & 64) + 32 * ((r6 >> 2) & 1) + 4 * (r6 >> 3) + (r6 & 3)) : rr;
#pragma unroll
    for (int hq = 0; hq < 2; ++hq) {
        float v[8];
#pragma unroll
        for (int q = 0; q < 8; ++q) v[q] = tile[(ks + hq * 8 + q) * 129 + sc] * scale;
        u32x4 w; w.x = cvt_pk_bf16(v[0], v[1]); w.y = cvt_pk_bf16(v[2], v[3]); w.z = cvt_pk_bf16(v[4], v[5]); w.w = cvt_pk_bf16(v[6], v[7]);
        *(u32x4*)(dst + (size_t)(r0 + rr) * dld + k0 + ks + hq * 8) = w;
    }
}

__device__ __forceinline__ void phase_prep(unsigned char* shm, const Params& p, int set, int first, int stride) {
    constexpr int J0 = 704, J1 = J0 + 352, J2 = J1 + 704, J3 = J2 + 352, J4 = J3 + 192, J5 = J4 + 96, J6 = J5 + 192, J7 = J6 + 256, J8 = J7 + 256, J9 = J8 + 144, J10 = J9 + 1;
    unsigned char* ws = p.ws;
    const int tid = threadIdx.x;
    constexpr int V0 = J1 + (J10 - J8), V1 = J8 - J1;
    for (int v = first; v < (set ? V1 : V0); v += stride) {
        const int job = set ? v + J1 : (v < J1 ? v : v - J1 + J8);
        if (job < J0 || (job >= J1 && job < J2)) {
            const bool second = job >= J1; const int jj = second ? job - J1 : job; const int rg = jj >> 4, kb = jj & 15;
            const int pn = rg >> 1, bj = rg & 1;
            prep_tile(shm, second ? p.w13_2 : p.w13_1, 5632, 64 * kb, bj * DFF + 128 * pn, (bf16_t*)(ws + (second ? OFF_WB13_2 : OFF_WB13_1)), 1024, 128 * rg, 64 * kb, false, 1.f);
        } else if (job < J1 || (job >= J2 && job < J3)) {
            const bool second = job >= J2; const int jj = second ? job - J2 : job - J0; const int rg = jj / 44, kb = jj % 44;
            prep_tile(shm, second ? p.w2_2 : p.w2_1, 1024, 64 * kb, 128 * rg, (bf16_t*)(ws + (second ? OFF_WB2_2 : OFF_WB2_1)), DFF, 128 * rg, 64 * kb, false, 1.f);
        } else if (job < J4) {
            const int jj = job - J3, rg = jj >> 4, kb = jj & 15;
            const int sc0 = rg < 4 ? 128 * rg : 128 * rg + 512;
            prep_tile(shm, p.w_in, 2560, 64 * kb, sc0, (bf16_t*)(ws + OFF_WBIN), 1024, 128 * rg, 64 * kb, rg < 4, (rg >= 2 && rg < 4) ? 0.125f : 1.f);
        } else if (job < J5) {
            const int jj = job - J4, rg = jj >> 4, kb = jj & 15;
            const int sc0 = rg < 2 ? 256 + 128 * rg : 512 + 128 * (rg - 2);
            prep_tile(shm, p.w_in, 2560, 64 * kb, sc0, (bf16_t*)(ws + OFF_WSW), 1024, 128 * rg, 64 * kb, rg < 2, rg < 2 ? 0.125f : 1.f);
        } else if (job < J6) {
            const int jj = job - J5, rg = jj / 24, kb = jj % 24;
            prep_tile(shm, p.w_out, 1024, kb < 8 ? 64 * kb : 64 * (kb - 8), 128 * rg, (bf16_t*)(ws + OFF_WOUT3), 1536, 128 * rg, 64 * kb, false, 1.f);
        } else if (job < J7) {
            const int jj = job - J6, g = jj >> 6, k0 = (jj & 63) * 16;
            float* wl = (float*)shm;
            float* trig = wl + 16 * 128;
            __syncthreads();
            for (int q = tid; q < 16 * 128; q += 512) wl[q] = p.w_in[(size_t)(k0 + (q >> 7)) * 2560 + 2048 + g * 128 + (q & 127)];
            if (tid < 128) trig[tid] = cospif((float)tid * (1.0f / 64.0f));
            __syncthreads();
            const int pm = tid & 255, kh = tid >> 8, part = pm >> 7, m = pm & 127;
            float a[8];
#pragma unroll
            for (int q = 0; q < 8; ++q) a[q] = 0.f;
            for (int c = 0; c < 128; ++c) {
                const int idx = (m * c) & 127;
                const float tr = part ? -trig[(idx + 96) & 127] : trig[idx];
#pragma unroll
                for (int q = 0; q < 8; ++q) a[q] += wl[(kh * 8 + q) * 128 + c] * tr;
            }
            u32x4 w; const float sc = 1.0f / 512.0f;
            w.x = cvt_pk_bf16(a[0] * sc, a[1] * sc); w.y = cvt_pk_bf16(a[2] * sc, a[3] * sc); w.z = cvt_pk_bf16(a[4] * sc, a[5] * sc); w.w = cvt_pk_bf16(a[6] * sc, a[7] * sc);
            *(u32x4*)((bf16_t*)(ws + OFF_WSW) + (size_t)(768 + part * 512 + g * 128 + m) * 1024 + k0 + kh * 8) = w;
        } else if (job < J8) {
            const int jj = job - J7; float* ct = (float*)shm;
            __syncthreads();
            for (int q = tid; q < 2048; q += 512) ct[q] = cospif((float)q * (1.0f / 1024.0f));
            __syncthreads();
            bf16_t* TT = (bf16_t*)(ws + OFF_TT);
            for (int q = tid; q < 8 * 256; q += 512) {
                const int k = jj * 8 + (q >> 8), pc = q & 255, part = pc >> 7, n0 = (pc & 127) * 8;
                float v[8];
#pragma unroll
                for (int e = 0; e < 8; ++e) { const int idx = (k * (n0 + e)) & 2047; v[e] = part ? ct[(idx + 1536) & 2047] : ct[idx]; }
                u32x4 w; w.x = cvt_pk_bf16(v[0], v[1]); w.y = cvt_pk_bf16(v[2], v[3]); w.z = cvt_pk_bf16(v[4], v[5]); w.w = cvt_pk_bf16(v[6], v[7]);
                *(u32x4*)(TT + (size_t)k * 2048 + part * 1024 + n0) = w;
            }
        } else if (job < J9) {
            const int jj = job - J8, col0 = jj * 64; const int wid = tid >> 6, lane = tid & 63;
            float acc[33];
#pragma unroll
            for (int b = 0; b < 33; ++b) acc[b] = 0.f;
            for (int kc = 0; kc < 2; ++kc) {
                const int kb = wid * 128 + kc * 64;
                float cv[33];
#pragma unroll
                for (int b = 0; b < 33; ++b) { const float cc = (b < 32) ? p.c[b * DM + kb + lane] : p.c_ctx[kb + lane]; cv[b] = cc / (1.0f + expf(-cc)); }
#pragma unroll 4
                for (int kk = 0; kk < 64; ++kk) {
                    const float wv = p.w_mod[(size_t)(kb + kk) * NMOD + col0 + lane];
#pragma unroll
                    for (int b = 0; b < 33; ++b) acc[b] += __uint_as_float(__builtin_amdgcn_readlane(__float_as_uint(cv[b]), kk)) * wv;
                }
            }
            float* red = (float*)shm;
            __syncthreads();
#pragma unroll
            for (int b = 0; b < 33; ++b) red[(wid * 33 + b) * 64 + lane] = acc[b];
            __syncthreads();
            float* mod = (float*)(ws + OFF_MOD);
            for (int q = tid; q < 33 * 64; q += 512) {
                const int b = q >> 6, cl = q & 63; float s = p.b_mod[col0 + cl];
#pragma unroll
                for (int w = 0; w < 8; ++w) s += red[(w * 33 + b) * 64 + cl];
                mod[(size_t)b * NMOD + col0 + cl] = s;
            }
        } else {
            float* R = (float*)(ws + OFF_ROPE);
            for (int q = tid; q < 1024; q += 512) {
                const int pos = q >> 4, f = q & 15;
                const float inv = powf(10000.0f, -(float)f / 16.0f); const float ang = (float)pos * inv;
                const float cs = cosf(ang), sn = sinf(ang);
                R[pos * 16 + f] = cs; R[1024 + pos * 16 + f] = sn; R[2048 + f * 64 + pos] = cs; R[3072 + f * 64 + pos] = sn;
            }
        }
    }
}

template <int R>
__device__ __forceinline__ void phase_norm_mod(const float* src_x, const float* src_c, int nrows, const float* g, const float* mod, int shift_off, int scale_off, bf16_t* dst, int row_begin = 0, bool local = false) {
    int tid_ = threadIdx.x; asm volatile("" : "+v"(tid_));
    const int wid = tid_ >> 6, lane = tid_ & 63;
    const int first = row_begin + (local ? wid : blockIdx.x * 8 * R + wid), step = local ? 8 * R : gridDim.x * 8 * R;
    for (int row0 = first; row0 < nrows; row0 += step) {
        const int b = row0 < MX ? (row0 >> 11) : 32;
        f32x4 v[R][4], gg[4], sc[4], sh[4];
#pragma unroll
        for (int j = 0; j < R; ++j) { const int row = row0 + 8 * j; const float* s = row < MX ? src_x + (size_t)row * DM : src_c + (size_t)(row - MX) * DM;
#pragma unroll
            for (int i = 0; i < 4; ++i) v[j][i] = (row < nrows) ? *(const f32x4*)(s + i * 256 + lane * 4) : (f32x4){0.f, 0.f, 0.f, 0.f}; }
#pragma unroll
        for (int i = 0; i < 4; ++i) { const int col = i * 256 + lane * 4; gg[i] = *(const f32x4*)(g + col); sc[i] = *(const f32x4*)(mod + (size_t)b * NMOD + scale_off + col) + 1.0f; sh[i] = *(const f32x4*)(mod + (size_t)b * NMOD + shift_off + col); }
#pragma unroll
        for (int j = 0; j < R; ++j) {
            const int row = row0 + 8 * j;
            float ss = 0.f;
#pragma unroll
            for (int i = 0; i < 4; ++i) ss += v[j][i][0] * v[j][i][0] + v[j][i][1] * v[j][i][1] + v[j][i][2] * v[j][i][2] + v[j][i][3] * v[j][i][3];
#pragma unroll
            for (int o = 32; o >= 1; o >>= 1) ss += __shfl_xor(ss, o);
            const float r = rsqrtf(ss * (1.0f / 1024.0f) + 1e-6f);
            if (row < nrows) {
#pragma unroll
                for (int i = 0; i < 4; ++i) { const f32x4 y = (v[j][i] * r) * gg[i] * sc[i] + sh[i]; u32x2 w; w.x = cvt_pk_bf16(y[0], y[1]); w.y = cvt_pk_bf16(y[2], y[3]);
                    *(u32x2*)(dst + (size_t)row * DM + i * 256 + lane * 4) = w; }
            }
        }
    }
}
template <int R>
__device__ __forceinline__ void phase_norm_mod_bf(const bf16_t* src, int nrows, const float* g, const float* mod, int shift_off, int scale_off, bf16_t* dst, int row_begin = 0) {
    int tid_ = threadIdx.x; asm volatile("" : "+v"(tid_));
    const int wid = tid_ >> 6, lane = tid_ & 63;
    for (int row0 = row_begin + blockIdx.x * 8 * R + wid; row0 < nrows; row0 += gridDim.x * 8 * R) {
        const int b = row0 < MX ? (row0 >> 11) : 32;
        u32x4 v[R][2]; f32x4 gg[2][2], sc[2][2], sh[2][2];
#pragma unroll
        for (int j = 0; j < R; ++j)
#pragma unroll
            for (int i = 0; i < 2; ++i) v[j][i] = *(const u32x4*)(src + (size_t)(row0 + 8 * j) * DM + i * 512 + lane * 8);
#pragma unroll
        for (int i = 0; i < 2; ++i)
#pragma unroll
            for (int n = 0; n < 2; ++n) { const int col = i * 512 + lane * 8 + 4 * n; gg[i][n] = *(const f32x4*)(g + col); sc[i][n] = *(const f32x4*)(mod + (size_t)b * NMOD + scale_off + col) + 1.0f; sh[i][n] = *(const f32x4*)(mod + (size_t)b * NMOD + shift_off + col); }
#pragma unroll
        for (int j = 0; j < R; ++j) {
            f32x4 x[2][2]; float ss = 0.f;
#pragma unroll
            for (int i = 0; i < 2; ++i) { x[i][0] = (f32x4){bf_lo(v[j][i].x), bf_hi(v[j][i].x), bf_lo(v[j][i].y), bf_hi(v[j][i].y)}; x[i][1] = (f32x4){bf_lo(v[j][i].z), bf_hi(v[j][i].z), bf_lo(v[j][i].w), bf_hi(v[j][i].w)};
                ss += x[i][0][0] * x[i][0][0] + x[i][0][1] * x[i][0][1] + x[i][0][2] * x[i][0][2] + x[i][0][3] * x[i][0][3] + x[i][1][0] * x[i][1][0] + x[i][1][1] * x[i][1][1] + x[i][1][2] * x[i][1][2] + x[i][1][3] * x[i][1][3]; }
#pragma unroll
            for (int o = 32; o >= 1; o >>= 1) ss += __shfl_xor(ss, o);
            const float r = rsqrtf(ss * (1.0f / 1024.0f) + 1e-6f);
#pragma unroll
            for (int i = 0; i < 2; ++i) { const f32x4 y0 = (x[i][0] * r) * gg[i][0] * sc[i][0] + sh[i][0], y1 = (x[i][1] * r) * gg[i][1] * sc[i][1] + sh[i][1];
                u32x4 w; w.x = cvt_pk_bf16(y0[0], y0[1]); w.y = cvt_pk_bf16(y0[2], y0[3]); w.z = cvt_pk_bf16(y1[0], y1[1]); w.w = cvt_pk_bf16(y1[2], y1[3]);
                *(u32x4*)(dst + (size_t)(row0 + 8 * j) * DM + i * 512 + lane * 8) = w; }
        }
    }
}

__device__ __forceinline__ void phase_norm_mix_pairs(const float* src, const float* g, const float* mod, int shift_off, int scale_off, bf16_t* dst, bf16_t* A2e, bf16_t* A2o) {
    int tid_ = threadIdx.x; asm volatile("" : "+v"(tid_));
    const int wid = tid_ >> 6, lane = tid_ & 63;
    for (int it = blockIdx.x * 8 + wid; it < 32 * 1025; it += gridDim.x * 8) {
        const int b = it / 1025, n = it - b * 1025;
        const bool pair = (n >= 1) && (n <= 1023);
        const int r1 = b * 2048 + n, r2 = pair ? b * 2048 + 2048 - n : r1;
        const float* s1 = src + (size_t)r1 * DM; const float* s2 = src + (size_t)r2 * DM;
        f32x4 v1[4], v2[4], gg[4], sc[4], sh[4]; float ss1 = 0.f, ss2 = 0.f;
#pragma unroll
        for (int i = 0; i < 4; ++i) { v1[i] = *(const f32x4*)(s1 + i * 256 + lane * 4); v2[i] = *(const f32x4*)(s2 + i * 256 + lane * 4); }
#pragma unroll
        for (int i = 0; i < 4; ++i) { const int col = i * 256 + lane * 4; gg[i] = *(const f32x4*)(g + col); sc[i] = *(const f32x4*)(mod + (size_t)b * NMOD + scale_off + col); sh[i] = *(const f32x4*)(mod + (size_t)b * NMOD + shift_off + col); }
#pragma unroll
        for (int i = 0; i < 4; ++i) { ss1 += v1[i][0] * v1[i][0] + v1[i][1] * v1[i][1] + v1[i][2] * v1[i][2] + v1[i][3] * v1[i][3]; ss2 += v2[i][0] * v2[i][0] + v2[i][1] * v2[i][1] + v2[i][2] * v2[i][2] + v2[i][3] * v2[i][3]; }
#pragma unroll
        for (int o = 32; o >= 1; o >>= 1) { ss1 += __shfl_xor(ss1, o); ss2 += __shfl_xor(ss2, o); }
        const float ra = rsqrtf(ss1 * (1.0f / 1024.0f) + 1e-6f), rb = rsqrtf(ss2 * (1.0f / 1024.0f) + 1e-6f);
        u32x2 w1[4], w2[4], we[4], wo[4];
#pragma unroll
        for (int i = 0; i < 4; ++i) {
            const f32x4 y1 = (v1[i] * ra) * gg[i] * (sc[i] + 1.0f) + sh[i], y2 = (v2[i] * rb) * gg[i] * (sc[i] + 1.0f) + sh[i];
            const f32x4 ye = pair ? (y1 + y2) : y1, yo = pair ? (y1 - y2) : (f32x4){0.f, 0.f, 0.f, 0.f};
            w1[i].x = cvt_pk_bf16(y1[0], y1[1]); w1[i].y = cvt_pk_bf16(y1[2], y1[3]); w2[i].x = cvt_pk_bf16(y2[0], y2[1]); w2[i].y = cvt_pk_bf16(y2[2], y2[3]);
            we[i].x = cvt_pk_bf16(ye[0], ye[1]); we[i].y = cvt_pk_bf16(ye[2], ye[3]); wo[i].x = cvt_pk_bf16(yo[0], yo[1]); wo[i].y = cvt_pk_bf16(yo[2], yo[3]);
        }
#pragma unroll
        for (int i = 0; i < 4; ++i) {
            const int col = i * 256 + lane * 4;
            *(u32x2*)(dst + (size_t)r1 * DM + col) = w1[i];
            if (pair) *(u32x2*)(dst + (size_t)r2 * DM + col) = w2[i];
            if (n < 1024) { *(u32x2*)(A2e + ((size_t)b * 1024 + n) * DM + col) = we[i]; *(u32x2*)(A2o + ((size_t)b * 1024 + n) * DM + col) = wo[i]; }
        }
    }
}
__device__ __forceinline__ void phase_norm_mix_pairs_bf(const bf16_t* src, const float* g, const float* mod, int shift_off, int scale_off, bf16_t* dst, bf16_t* A2e, bf16_t* A2o) {
    int tid_ = threadIdx.x; asm volatile("" : "+v"(tid_));
    const int wid = tid_ >> 6, lane = tid_ & 63;
    constexpr int PP = 4, NG = (1025 + PP - 1) / PP;
    for (int gi = blockIdx.x * 8 + wid; gi < 32 * NG; gi += gridDim.x * 8) {
        const int b = gi / NG, n0 = (gi - b * NG) * PP;
        u32x4 v1[PP][2], v2[PP][2]; f32x4 gg[2][2], sc[2][2], sh[2][2];
#pragma unroll
        for (int q = 0; q < PP; ++q) {
            const int n = n0 + q < 1025 ? n0 + q : 1024;
            const bool pair = (n >= 1) && (n <= 1023);
            const int r1 = b * 2048 + n, r2 = pair ? b * 2048 + 2048 - n : r1;
#pragma unroll
            for (int i = 0; i < 2; ++i) { v1[q][i] = *(const u32x4*)(src + (size_t)r1 * DM + i * 512 + lane * 8); v2[q][i] = *(const u32x4*)(src + (size_t)r2 * DM + i * 512 + lane * 8); }
        }
#pragma unroll
        for (int i = 0; i < 2; ++i)
#pragma unroll
            for (int n = 0; n < 2; ++n) { const int col = i * 512 + lane * 8 + 4 * n; gg[i][n] = *(const f32x4*)(g + col); sc[i][n] = *(const f32x4*)(mod + (size_t)b * NMOD + scale_off + col) + 1.0f; sh[i][n] = *(const f32x4*)(mod + (size_t)b * NMOD + shift_off + col); }
#pragma unroll
        for (int q = 0; q < PP; ++q) {
            const int n = n0 + q;
            const bool valid = n < 1025, pair = (n >= 1) && (n <= 1023);
            const int r1 = b * 2048 + n, r2 = b * 2048 + 2048 - n;
            f32x4 x1[2][2], x2[2][2]; float ss1 = 0.f, ss2 = 0.f;
#pragma unroll
            for (int i = 0; i < 2; ++i) {
                x1[i][0] = (f32x4){bf_lo(v1[q][i].x), bf_hi(v1[q][i].x), bf_lo(v1[q][i].y), bf_hi(v1[q][i].y)}; x1[i][1] = (f32x4){bf_lo(v1[q][i].z), bf_hi(v1[q][i].z), bf_lo(v1[q][i].w), bf_hi(v1[q][i].w)};
                x2[i][0] = (f32x4){bf_lo(v2[q][i].x), bf_hi(v2[q][i].x), bf_lo(v2[q][i].y), bf_hi(v2[q][i].y)}; x2[i][1] = (f32x4){bf_lo(v2[q][i].z), bf_hi(v2[q][i].z), bf_lo(v2[q][i].w), bf_hi(v2[q][i].w)};
#pragma unroll
                for (int n2 = 0; n2 < 2; ++n2) { ss1 += x1[i][n2][0] * x1[i][n2][0] + x1[i][n2][1] * x1[i][n2][1] + x1[i][n2][2] * x1[i][n2][2] + x1[i][n2][3] * x1[i][n2][3];
                                                  ss2 += x2[i][n2][0] * x2[i][n2][0] + x2[i][n2][1] * x2[i][n2][1] + x2[i][n2][2] * x2[i][n2][2] + x2[i][n2][3] * x2[i][n2][3]; }
            }
#pragma unroll
            for (int o = 32; o >= 1; o >>= 1) { ss1 += __shfl_xor(ss1, o); ss2 += __shfl_xor(ss2, o); }
            const float ra = rsqrtf(ss1 * (1.0f / 1024.0f) + 1e-6f), rb = rsqrtf(ss2 * (1.0f / 1024.0f) + 1e-6f);
            if (valid) {
#pragma unroll
                for (int i = 0; i < 2; ++i) {
                    const int col = i * 512 + lane * 8;
                    f32x4 y1[2], y2[2], ye[2], yo[2];
#pragma unroll
                    for (int n2 = 0; n2 < 2; ++n2) { y1[n2] = (x1[i][n2] * ra) * gg[i][n2] * sc[i][n2] + sh[i][n2]; y2[n2] = (x2[i][n2] * rb) * gg[i][n2] * sc[i][n2] + sh[i][n2];
                        ye[n2] = pair ? (y1[n2] + y2[n2]) : y1[n2]; yo[n2] = pair ? (y1[n2] - y2[n2]) : (f32x4){0.f, 0.f, 0.f, 0.f}; }
                    u32x4 w1, w2, we, wo;
                    w1.x = cvt_pk_bf16(y1[0][0], y1[0][1]); w1.y = cvt_pk_bf16(y1[0][2], y1[0][3]); w1.z = cvt_pk_bf16(y1[1][0], y1[1][1]); w1.w = cvt_pk_bf16(y1[1][2], y1[1][3]);
                    w2.x = cvt_pk_bf16(y2[0][0], y2[0][1]); w2.y = cvt_pk_bf16(y2[0][2], y2[0][3]); w2.z = cvt_pk_bf16(y2[1][0], y2[1][1]); w2.w = cvt_pk_bf16(y2[1][2], y2[1][3]);
                    we.x = cvt_pk_bf16(ye[0][0], ye[0][1]); we.y = cvt_pk_bf16(ye[0][2], ye[0][3]); we.z = cvt_pk_bf16(ye[1][0], ye[1][1]); we.w = cvt_pk_bf16(ye[1][2], ye[1][3]);
                    wo.x = cvt_pk_bf16(yo[0][0], yo[0][1]); wo.y = cvt_pk_bf16(yo[0][2], yo[0][3]); wo.z = cvt_pk_bf16(yo[1][0], yo[1][1]); wo.w = cvt_pk_bf16(yo[1][2], yo[1][3]);
                    *(u32x4*)(dst + (size_t)r1 * DM + col) = w1;
                    if (pair) *(u32x4*)(dst + (size_t)r2 * DM + col) = w2;
                    if (n < 1024) { *(u32x4*)(A2e + ((size_t)b * 1024 + n) * DM + col) = we; *(u32x4*)(A2o + ((size_t)b * 1024 + n) * DM + col) = wo; }
                }
            }
        }
    }
}

__device__ __forceinline__ void phase_ych(const bf16_t* A2, const bf16_t* Wc, float* YCH) {
    int tid_ = threadIdx.x; asm volatile("" : "+v"(tid_));
    const int wid = tid_ >> 6, lane = tid_ & 63;
    for (int o = blockIdx.x * 8 + wid; o < 32 * 512; o += gridDim.x * 8) {
        const int b = o >> 9, gm = o & 511;
        const bf16_t* a = A2 + ((size_t)b * 2048 + 1024) * DM + lane * 16; const bf16_t* w = Wc + (size_t)gm * DM + lane * 16;
        float acc = 0.f;
#pragma unroll
        for (int q = 0; q < 2; ++q) { const u32x4 av = *(const u32x4*)(a + q * 8), wv = *(const u32x4*)(w + q * 8);
            acc += bf_lo(av.x) * bf_lo(wv.x) + bf_hi(av.x) * bf_hi(wv.x) + bf_lo(av.y) * bf_lo(wv.y) + bf_hi(av.y) * bf_hi(wv.y) + bf_lo(av.z) * bf_lo(wv.z) + bf_hi(av.z) * bf_hi(wv.z) + bf_lo(av.w) * bf_lo(wv.w) + bf_hi(av.w) * bf_hi(wv.w); }
#pragma unroll
        for (int sft = 32; sft >= 1; sft >>= 1) acc += __shfl_xor(acc, sft);
        if (lane == 0) YCH[o] = acc;
    }
}
__device__ __forceinline__ void phase_final_norm(const bf16_t* hb, float* out, const float* g) {
    int tid_ = threadIdx.x; asm volatile("" : "+v"(tid_));
    const int wid = tid_ >> 6, lane = tid_ & 63;
    constexpr int R = 8;
    f32x4 gg[2][2];
#pragma unroll
    for (int i = 0; i < 2; ++i) { gg[i][0] = *(const f32x4*)(g + i * 512 + lane * 8); gg[i][1] = *(const f32x4*)(g + i * 512 + lane * 8 + 4); }
    for (int row0 = blockIdx.x * 8 * R + wid; row0 < MX; row0 += gridDim.x * 8 * R) {
        u32x4 v[R][2];
#pragma unroll
        for (int j = 0; j < R; ++j)
#pragma unroll
            for (int i = 0; i < 2; ++i) v[j][i] = *(const u32x4*)(hb + (size_t)(row0 + 8 * j) * DM + i * 512 + lane * 8);
#pragma unroll
        for (int j = 0; j < R; ++j) {
            f32x4 x[2][2]; float ss = 0.f;
#pragma unroll
            for (int i = 0; i < 2; ++i) { x[i][0] = (f32x4){bf_lo(v[j][i].x), bf_hi(v[j][i].x), bf_lo(v[j][i].y), bf_hi(v[j][i].y)}; x[i][1] = (f32x4){bf_lo(v[j][i].z), bf_hi(v[j][i].z), bf_lo(v[j][i].w), bf_hi(v[j][i].w)};
                ss += x[i][0][0] * x[i][0][0] + x[i][0][1] * x[i][0][1] + x[i][0][2] * x[i][0][2] + x[i][0][3] * x[i][0][3] + x[i][1][0] * x[i][1][0] + x[i][1][1] * x[i][1][1] + x[i][1][2] * x[i][1][2] + x[i][1][3] * x[i][1][3]; }
#pragma unroll
            for (int o = 32; o >= 1; o >>= 1) ss += __shfl_xor(ss, o);
            const float r = rsqrtf(ss * (1.0f / 1024.0f) + 1e-6f);
#pragma unroll
            for (int i = 0; i < 2; ++i) { float* o = out + (size_t)(row0 + 8 * j) * DM + i * 512 + lane * 8; *(f32x4*)(o) = (x[i][0] * r) * gg[i][0]; *(f32x4*)(o + 4) = (x[i][1] * r) * gg[i][1]; }
        }
    }
}

struct RetStep { size_t tok0; size_t NT; const bf16_t* vt; const bf16_t* kz; bool isctx; };
__device__ __forceinline__ RetStep ret_step(const Params& p, int step, int b, int dir) {
    RetStep r;
    r.isctx = step < 2;
    if (r.isctx) { const int ci = dir ? 1 - step : step; r.tok0 = (size_t)b * 256 + ci * 128; r.NT = MC; r.vt = (const bf16_t*)(p.ws + OFF_VTC); r.kz = (const bf16_t*)(p.ws + OFF_KTZC); }
    else { const int s = step - 2; const int ci = dir ? 15 - s : s; r.tok0 = (size_t)b * 2048 + ci * 128; r.NT = MX; r.vt = (const bf16_t*)(p.ws + OFF_VT); r.kz = (const bf16_t*)(p.ws + OFF_KTZ); }
    return r;
}
__device__ __forceinline__ void retention_item(LAS unsigned char* lds, const Params& p, int item) {
    int tid_ = threadIdx.x; asm volatile("" : "+v"(tid_));
    const int tid = tid_, wid = __builtin_amdgcn_readfirstlane(tid >> 6), lane = tid & 63, fr = lane & 15, fq = lane >> 4;
    const int b = item >> 3, h = (item >> 1) & 3, dir = item & 1;
    const float l2g = p.ret_log_decay[dir * 4 + h] * 1.4426950408889634f;
    const float decayC = exp2f(128.0f * l2g);
    LAS bf16_t* Ks = (LAS bf16_t*)lds;
    LAS bf16_t* Vts = Ks + 128 * 80;
    LAS bf16_t* Kzs = Vts + 128 * 136;
    LAS bf16_t* Sts = Kzs + 64 * 136;
    const bf16_t* P = (const bf16_t*)(p.ws + OFF_P);
    bf16_t* CAT = (bf16_t*)(p.ws + OFF_A);
    const int c = 16 * wid + fr;
    const float xi = exp2f((float)(dir ? (128 - c) : (c + 1)) * l2g);
    f32x4 accSt[4];
#pragma unroll
    for (int db = 0; db < 4; ++db) accSt[db] = (f32x4){0.f, 0.f, 0.f, 0.f};
    u32x4 pk[2], pv[4], pz[2]; bf16x8 pq[2]; u32x2 pg[8];
#pragma unroll
    for (int q = 0; q < 2; ++q) { pk[q] = (u32x4){0u, 0u, 0u, 0u}; pq[q] = __builtin_bit_cast(bf16x8, pk[q]); }
#pragma unroll
    for (int q = 0; q < 8; ++q) pg[q] = (u32x2){0u, 0u};
    {   const RetStep r = ret_step(p, 0, b, dir);
#pragma unroll
        for (int q = 0; q < 4; ++q) { const int pc = tid + q * 512, row = pc >> 4, seg = pc & 15; pv[q] = *(const u32x4*)(r.vt + (size_t)(128 * h + row) * r.NT + r.tok0 + seg * 8); }
#pragma unroll
        for (int q = 0; q < 2; ++q) { const int pc = tid + q * 512, row = pc >> 4, seg = pc & 15; pz[q] = *(const u32x4*)(r.kz + (size_t)(dir * 256 + 64 * h + row) * r.NT + r.tok0 + seg * 8); }
    }
    for (int step = 0; step < 18; ++step) {
        const RetStep cur = ret_step(p, step, b, dir);
        if (!cur.isctx) {
#pragma unroll
            for (int q = 0; q < 2; ++q) { const int pc = tid + q * 512, row = pc >> 3, seg = pc & 7; *(LAS u32x4*)(Ks + row * 80 + seg * 8) = pk[q]; }
        }
#pragma unroll
        for (int q = 0; q < 4; ++q) { const int pc = tid + q * 512, row = pc >> 4, seg = pc & 15; *(LAS u32x4*)(Vts + row * 136 + seg * 8) = pv[q]; }
#pragma unroll
        for (int q = 0; q < 2; ++q) { const int pc = tid + q * 512, row = pc >> 4, seg = pc & 15; *(LAS u32x4*)(Kzs + row * 136 + seg * 8) = pz[q]; }
        bf16x8 bq[2]; bq[0] = pq[0]; bq[1] = pq[1];
        if (step + 1 < 18) {
            const RetStep nx = ret_step(p, step + 1, b, dir);
            if (!nx.isctx) {
#pragma unroll
                for (int q = 0; q < 2; ++q) { const int pc = tid + q * 512, row = pc >> 3, seg = pc & 7; pk[q] = *(const u32x4*)(P + (nx.tok0 + row) * PW + 256 + 64 * h + seg * 8); }
                const bf16_t* qrow = P + (nx.tok0 + c) * PW + 64 * h + 8 * fq;
                pq[0] = *(const bf16x8*)(qrow); pq[1] = *(const bf16x8*)(qrow + 32);
            }
#pragma unroll
            for (int q = 0; q < 4; ++q) { const int pc = tid + q * 512, row = pc >> 4, seg = pc & 15; pv[q] = *(const u32x4*)(nx.vt + (size_t)(128 * h + row) * nx.NT + nx.tok0 + seg * 8); }
#pragma unroll
            for (int q = 0; q < 2; ++q) { const int pc = tid + q * 512, row = pc >> 4, seg = pc & 15; pz[q] = *(const u32x4*)(nx.kz + (size_t)(dir * 256 + 64 * h + row) * nx.NT + nx.tok0 + seg * 8); }
            if (step == 1) {
                const bf16_t* grow = P + (nx.tok0 + c) * PW + 512 + dir * 512 + 128 * h + 4 * fq;
#pragma unroll
                for (int eb = 0; eb < 8; ++eb) pg[eb] = *(const u32x2*)(grow + 16 * eb);
            }
        }
        __syncthreads();
        if (!cur.isctx) {
            bf16x8 qx[2];
#pragma unroll
            for (int s = 0; s < 2; ++s) { const u32x4 raw = __builtin_bit_cast(u32x4, bq[s]); u32x4 o;
                o.x = cvt_pk_bf16(bf_lo(raw.x) * xi, bf_hi(raw.x) * xi); o.y = cvt_pk_bf16(bf_lo(raw.y) * xi, bf_hi(raw.y) * xi);
                o.z = cvt_pk_bf16(bf_lo(raw.z) * xi, bf_hi(raw.z) * xi); o.w = cvt_pk_bf16(bf_lo(raw.w) * xi, bf_hi(raw.w) * xi);
                qx[s] = __builtin_bit_cast(bf16x8, o); }
            bf16x8 pf[4];
#pragma unroll
            for (int ks = 0; ks < 4; ++ks) {
                const bool live = dir ? (2 * ks + 1 >= wid) : (2 * ks <= wid);
                u32x4 o = {0u, 0u, 0u, 0u};
                if (live) {
                    f32x4 sc[2];
                    bf16x8 ka[2][2];
#pragma unroll
                    for (int q = 0; q < 2; ++q)
#pragma unroll
                        for (int s = 0; s < 2; ++s) ka[q][s] = *(const LAS bf16x8*)(Ks + (16 * (2 * ks + q) + fr) * 80 + 32 * s + 8 * fq);
                    __builtin_amdgcn_sched_barrier(0);
                    __builtin_amdgcn_s_setprio(1);
#pragma unroll
                    for (int q = 0; q < 2; ++q) { sc[q] = (f32x4){0.f, 0.f, 0.f, 0.f};
#pragma unroll
                        for (int s = 0; s < 2; ++s) sc[q] = __builtin_amdgcn_mfma_f32_16x16x32_bf16(ka[q][s], bq[s], sc[q], 0, 0, 0); }
                    __builtin_amdgcn_s_setprio(0);
#pragma unroll
                    for (int q = 0; q < 2; ++q) { const int mb = 2 * ks + q;
#pragma unroll
                        for (int r = 0; r < 4; ++r) { const int m = 16 * mb + 4 * fq + r; const int diff = dir ? (m - c) : (c - m); sc[q][r] = diff >= 0 ? sc[q][r] * __builtin_amdgcn_exp2f((float)diff * l2g) : 0.f; }
                    }
                    o.x = cvt_pk_bf16(sc[0][0], sc[0][1]); o.y = cvt_pk_bf16(sc[0][2], sc[0][3]); o.z = cvt_pk_bf16(sc[1][0], sc[1][1]); o.w = cvt_pk_bf16(sc[1][2], sc[1][3]);
                }
                pf[ks] = __builtin_bit_cast(bf16x8, o);
            }
            f32x4 accO[8];
#pragma unroll
            for (int eb = 0; eb < 8; ++eb) accO[eb] = (f32x4){0.f, 0.f, 0.f, 0.f};
#pragma unroll
            for (int s = 0; s < 2; ++s) {
                bf16x8 sa[8];
#pragma unroll
                for (int eb = 0; eb < 8; ++eb) sa[eb] = *(const LAS bf16x8*)(Sts + (16 * eb + fr) * 80 + 32 * s + 8 * fq);
                __builtin_amdgcn_sched_barrier(0);
                __builtin_amdgcn_s_setprio(1);
#pragma unroll
                for (int eb = 0; eb < 8; ++eb) accO[eb] = __builtin_amdgcn_mfma_f32_16x16x32_bf16(sa[eb], qx[s], accO[eb], 0, 0, 0);
                __builtin_amdgcn_s_setprio(0);
                __builtin_amdgcn_sched_barrier(0);
            }
#pragma unroll
            for (int ks = 0; ks < 4; ++ks) {
                const bool live = dir ? (2 * ks + 1 >= wid) : (2 * ks <= wid);
                if (live) {
                    u32x4 va[8];
#pragma unroll
                    for (int eb = 0; eb < 8; ++eb) {
                        const u32x2 lo = *(const LAS u32x2*)(Vts + (16 * eb + fr) * 136 + 32 * ks + 4 * fq), hi = *(const LAS u32x2*)(Vts + (16 * eb + fr) * 136 + 32 * ks + 16 + 4 * fq);
                        va[eb] = (u32x4){lo.x, lo.y, hi.x, hi.y};
                    }
                    __builtin_amdgcn_sched_barrier(0);
                    __builtin_amdgcn_s_setprio(1);
#pragma unroll
                    for (int eb = 0; eb < 8; ++eb) accO[eb] = __builtin_amdgcn_mfma_f32_16x16x32_bf16(__builtin_bit_cast(bf16x8, va[eb]), pf[ks], accO[eb], 0, 0, 0);
                    __builtin_amdgcn_s_setprio(0);
                    __builtin_amdgcn_sched_barrier(0);
                }
            }
            float sm = 0.f;
#pragma unroll
            for (int eb = 0; eb < 8; ++eb) sm += (accO[eb][0] + accO[eb][1]) + (accO[eb][2] + accO[eb][3]);
            sm += __shfl_xor(sm, 16); sm += __shfl_xor(sm, 32);
            const float mean = sm * (1.0f / 128.0f);
            float vq = 0.f;
#pragma unroll
            for (int eb = 0; eb < 8; ++eb) { const f32x4 d = accO[eb] - mean; vq += (d[0] * d[0] + d[1] * d[1]) + (d[2] * d[2] + d[3] * d[3]); }
            vq += __shfl_xor(vq, 16); vq += __shfl_xor(vq, 32);
            const float rstd = rsqrtf(vq * (1.0f / 128.0f) + 1e-6f);
            bf16_t* yrow = CAT + (cur.tok0 + c) * CATW + dir * 512 + 128 * h + 4 * fq;
#pragma unroll
            for (int eb = 0; eb < 8; ++eb) {
                const u32x2 gr = pg[eb];
                const f32x4 y = (accO[eb] - mean) * rstd;
                u32x2 w; w.x = cvt_pk_bf16(bf_lo(gr.x) * y[0], bf_hi(gr.x) * y[1]); w.y = cvt_pk_bf16(bf_lo(gr.y) * y[2], bf_hi(gr.y) * y[3]);
                *(u32x2*)(yrow + 16 * eb) = w;
            }
            if (step + 1 < 18) {
                const RetStep nx = ret_step(p, step + 1, b, dir);
                const bf16_t* grow = P + (nx.tok0 + c) * PW + 512 + dir * 512 + 128 * h + 4 * fq;
#pragma unroll
                for (int eb = 0; eb < 8; ++eb) pg[eb] = *(const u32x2*)(grow + 16 * eb);
            }
        }
#pragma unroll
        for (int db = 0; db < 4; ++db) accSt[db] = accSt[db] * decayC;
#pragma unroll
        for (int kh = 0; kh < 2; ++kh) {
            bf16x8 a[2], bb[2][4];
#pragma unroll
            for (int q = 0; q < 2; ++q) { const int ks = 2 * kh + q; a[q] = *(const LAS bf16x8*)(Vts + (16 * wid + fr) * 136 + 32 * ks + 8 * fq);
#pragma unroll
                for (int db = 0; db < 4; ++db) bb[q][db] = *(const LAS bf16x8*)(Kzs + (16 * db + fr) * 136 + 32 * ks + 8 * fq); }
            __builtin_amdgcn_sched_barrier(0);
            __builtin_amdgcn_s_setprio(1);
#pragma unroll
            for (int q = 0; q < 2; ++q)
#pragma unroll
                for (int db = 0; db < 4; ++db) accSt[db] = __builtin_amdgcn_mfma_f32_16x16x32_bf16(a[q], bb[q][db], accSt[db], 0, 0, 0);
            __builtin_amdgcn_s_setprio(0);
            __builtin_amdgcn_sched_barrier(0);
        }
        __syncthreads();
#pragma unroll
        for (int db = 0; db < 4; ++db)
#pragma unroll
            for (int r = 0; r < 4; ++r) Sts[(16 * wid + 4 * fq + r) * 80 + 16 * db + fr] = (bf16_t)(cvt_pk_bf16(accSt[db][r], 0.f) & 0xffffu);
    }
    __syncthreads();
}

#define XB_TMO      128
#define XB_XCNT(j)  (256  + 64 * (j))
#define XB_XSUB(j)  (1280 + 64 * (j))
#define XB_XGEN(j)  (2304 + 64 * (j))
#define XB_TOP      3328
#define XB_TOPGEN   3392
#define XCD_BAR_WORDS 3456
#define XB_SPIN_CAP (1u << 18)
__device__ __forceinline__ unsigned xb_ld(unsigned* p)              { return __hip_atomic_load(p, __ATOMIC_RELAXED, __HIP_MEMORY_SCOPE_AGENT); }
__device__ __forceinline__ unsigned xb_add(unsigned* p, unsigned v) { return __hip_atomic_fetch_add(p, v, __ATOMIC_RELAXED, __HIP_MEMORY_SCOPE_AGENT); }
__device__ __forceinline__ unsigned xb_xcc_id() { return (unsigned)__builtin_amdgcn_s_getreg((3 << 11) | 20) & 0xFu; }
#define XB_SPIN(cond, bar) do { unsigned _sp = 0; while (cond) { __builtin_amdgcn_s_sleep(1); \
    if ((++_sp & 255u) == 0u) { if (xb_ld(&(bar)[XB_TMO])) break; if (_sp > XB_SPIN_CAP) { atomicAdd(&(bar)[XB_TMO], 1u); break; } } } } while (0)
struct XcdBarrier { unsigned* bar; unsigned x; volatile LAS unsigned* st; };
__device__ __forceinline__ XcdBarrier xcd_barrier_post(unsigned* bar, volatile LAS unsigned* st) {
    XcdBarrier b; b.bar = bar; b.x = xb_xcc_id(); b.st = st;
    if (threadIdx.x == 0) (void)xb_add(&bar[XB_XCNT(b.x)], 1u);
    return b;
}
__device__ __forceinline__ void xcd_barrier_complete(unsigned* bar, unsigned x, unsigned& nloc, unsigned& nx) {
    const unsigned G = gridDim.x * gridDim.y * gridDim.z;
    unsigned sum, cnt, mine, sp = 0u;
    for (;;) {
        sum = 0u; cnt = 0u; mine = 0u;
#pragma unroll
        for (unsigned j = 0; j < 16; ++j) { const unsigned c = xb_ld(&bar[XB_XCNT(j)]); sum += c; cnt += (c > 0u) ? 1u : 0u; mine = (j == x) ? c : mine; }
        if (sum == G) break;
        __builtin_amdgcn_s_sleep(1);
        if ((++sp & 255u) == 0u) { if (xb_ld(&bar[XB_TMO])) break; if (sp > XB_SPIN_CAP) { atomicAdd(&bar[XB_TMO], 1u); break; } }
    }
    nloc = mine > 0u ? mine : 1u; nx = cnt > 0u ? cnt : 1u;
}
__device__ __forceinline__ void xcd_barrier(const XcdBarrier& b) {
    asm volatile("s_waitcnt vmcnt(0)" ::: "memory");
    __syncthreads();
    if (threadIdx.x == 0) {
        unsigned* bar = b.bar;
        __builtin_amdgcn_s_waitcnt(0);
        unsigned nloc = b.st[0], nx = b.st[1];
        if (nloc == 0u) { xcd_barrier_complete(bar, b.x, nloc, nx); b.st[0] = nloc; b.st[1] = nx; }
        const unsigned old = xb_add(&bar[XB_XSUB(b.x)], 1u);
        const unsigned gen = old / nloc;
        if (old + 1u == (gen + 1u) * nloc) {
            __builtin_amdgcn_fence(__ATOMIC_RELEASE, "agent");
            asm volatile("s_waitcnt vmcnt(0)" ::: "memory");
            const unsigned og = xb_add(&bar[XB_TOP], 1u);
            const unsigned tg = og / nx;
            if (og + 1u == (tg + 1u) * nx) xb_add(&bar[XB_TOPGEN], 1u);
            else XB_SPIN(xb_ld(&bar[XB_TOPGEN]) == tg, bar);
            __builtin_amdgcn_fence(__ATOMIC_ACQUIRE, "agent");
            xb_add(&bar[XB_XGEN(b.x)], 1u);
            asm volatile("s_waitcnt vmcnt(0)" ::: "memory");
        } else {
            XB_SPIN(xb_ld(&bar[XB_XGEN(b.x)]) == gen, bar);
            __builtin_amdgcn_fence(__ATOMIC_ACQUIRE, "agent");
            asm volatile("s_waitcnt vmcnt(0)" ::: "memory");
        }
    }
    __syncthreads();
}

#define GRID_SYNC() do { asm volatile("s_waitcnt vmcnt(0)" ::: "memory"); __syncthreads(); cg::this_grid().sync(); } while (0)
__global__ void __launch_bounds__(512, 2) fwd_megakernel(Params p) {
    extern __shared__ __attribute__((aligned(16))) unsigned char shm[];
    LAS unsigned char* lds = (LAS unsigned char*)shm;
    unsigned char* ws = p.ws;
    const float* mod = (const float*)(ws + OFF_MOD);
    bf16_t* Abuf = (bf16_t*)(ws + OFF_A);
    bf16_t* Hbuf = (bf16_t*)(ws + OFF_H);
    float* hc = (float*)(ws + OFF_HC);

    unsigned* barw = (unsigned*)(ws + OFF_BAR);
    if (blockIdx.x == 0) for (int i = threadIdx.x; i < XCD_BAR_WORDS; i += 512) barw[i] = 0u;
    volatile LAS unsigned* bst = (volatile LAS unsigned*)(lds + 131072);
    if (threadIdx.x < 4) bst[threadIdx.x] = 0u;
    phase_prep(shm, p, 0, (int)blockIdx.x, (int)gridDim.x);
    GRID_SYNC();
    const XcdBarrier xb = xcd_barrier_post(barw, bst);
    phase_norm_mod<8>(p.x, p.ctx, MT, p.norm_ffn1, mod, 0 * DM, 1 * DM, Abuf);
    xcd_barrier(xb);
    { EpiSwiGLU e; e.H = Hbuf; run_gemm(lds, Abuf, (const bf16_t*)(ws + OFF_WB13_1), MT, 5632, 1024, e); }
    xcd_barrier(xb);
    bf16_t* h1b = (bf16_t*)p.out;
    { EpiResidBfC e; e.res_x = p.x; e.res_c = p.ctx; e.hb = h1b; e.gate = mod + 2 * DM; e.gs = 0.5f; run_gemm(lds, Hbuf, (const bf16_t*)(ws + OFF_WB2_1), MT, 1024, DFF, e, 0, 1); }
    { const int rem = (int)((MT / 256 * 4) % gridDim.x);
      if (rem == 0) phase_prep(shm, p, 1, (int)blockIdx.x, (int)gridDim.x);
      else if ((int)blockIdx.x >= rem) phase_prep(shm, p, 1, (int)blockIdx.x - rem, (int)gridDim.x - rem); }
    xcd_barrier(xb);
    phase_norm_mix_pairs_bf(h1b, p.norm_mix, mod, 3 * DM, 4 * DM, Abuf, (bf16_t*)(ws + OFF_A2E), (bf16_t*)(ws + OFF_A2O));
    phase_norm_mod_bf<4>(h1b, MT, p.norm_mix, mod, 3 * DM, 4 * DM, Abuf, MX);
    xcd_barrier(xb);
    phase_ych(Abuf, (const bf16_t*)(ws + OFF_WSW) + (size_t)768 * 1024, (float*)(ws + OFF_YCH));
    { EpiInProj e; e.P = (bf16_t*)(ws + OFF_P); e.ropeA = (const float*)(ws + OFF_ROPE); e.KTZ = (bf16_t*)(ws + OFF_KTZ); e.lgd = p.ret_log_decay; run_gemm(lds, Abuf, (const bf16_t*)(ws + OFF_WBIN), MX, 1536, 1024, e); }
    { EpiSwapVF e; e.VT = (bf16_t*)(ws + OFF_VT); e.NT = MX;
      run_gemm(lds, (const bf16_t*)(ws + OFF_WSW) + (size_t)256 * 1024, Abuf, 512, MX, 1024, e); }
    { EpiSwapF e; e.YT = (bf16_t*)(ws + OFF_YT); e.part = 0;
      run_gemm(lds, (const bf16_t*)(ws + OFF_WSW) + (size_t)768 * 1024, (const bf16_t*)(ws + OFF_A2E), 512, 32768, 1024, e); }
    { EpiSwapF e; e.YT = (bf16_t*)(ws + OFF_YT); e.part = 1;
      run_gemm(lds, (const bf16_t*)(ws + OFF_WSW) + (size_t)1280 * 1024, (const bf16_t*)(ws + OFF_A2O), 512, 32768, 1024, e); }
    { EpiSwapK<false> e; e.KTZ = (bf16_t*)(ws + OFF_KTZC); e.ropeA = (const float*)(ws + OFF_ROPE); e.lgd = p.ret_log_decay; e.NT = MC;
      run_gemm(lds, (const bf16_t*)(ws + OFF_WSW), Abuf + (size_t)MX * DM, 256, MC, 1024, e, 256 - 32); }
    { EpiSwapVF e; e.VT = (bf16_t*)(ws + OFF_VTC); e.NT = MC;
      run_gemm(lds, (const bf16_t*)(ws + OFF_WSW) + (size_t)256 * 1024, Abuf + (size_t)MX * DM, 512, MC, 1024, e, 256 - 96); }
    xcd_barrier(xb);
    for (int item = blockIdx.x; item < 256; item += gridDim.x) retention_item(lds, p, item);
    { EpiFour e; e.CAT = Abuf; e.YCH = (const float*)(ws + OFF_YCH); run_gemm(lds, (const bf16_t*)(ws + OFF_TT), (const bf16_t*)(ws + OFF_YT), 2048, 16384, 2048, e); }
    xcd_barrier(xb);
    { EpiResidBfBf e; e.res_b = h1b; e.hb = (bf16_t*)(ws + OFF_H2B); e.gate = mod + 5 * DM; e.gs = 1.0f; run_gemm(lds, Abuf, (const bf16_t*)(ws + OFF_WOUT3), MX, 1024, 1536, e); }
    xcd_barrier(xb);
    phase_norm_mod_bf<8>((const bf16_t*)(ws + OFF_H2B), MX, p.norm_ffn2, mod, 6 * DM, 7 * DM, Abuf);
    xcd_barrier(xb);
    { EpiSwiGLU e; e.H = Hbuf; run_gemm(lds, Abuf, (const bf16_t*)(ws + OFF_WB13_2), MX, 5632, 1024, e); }
    xcd_barrier(xb);
    { EpiResidBfBf e; e.res_b = (const bf16_t*)(ws + OFF_H2B); e.hb = Abuf; e.gate = mod + 8 * DM; e.gs = 0.5f; run_gemm(lds, Hbuf, (const bf16_t*)(ws + OFF_WB2_2), MX, 1024, DFF, e, 0, 1); }
    xcd_barrier(xb);
    phase_final_norm(Abuf, p.out, p.norm_final);
}

extern "C" void kernel_launch(void* const* d_in, const int* in_sizes, int n_in, void* d_out, int out_size, void* d_ws, size_t ws_size, hipStream_t stream) {
    static int grid_blocks = 0;
    if (grid_blocks == 0) {
        if (n_in != 17 || ws_size < WS_END) { fprintf(stderr, "kernel_launch: unexpected n_in %d or ws_size %zu (< %zu)\n", n_in, ws_size, (size_t)WS_END); grid_blocks = -1; return; }
        int dev = 0, cus = 0, per_cu = 0;
        hipGetDevice(&dev);
        hipDeviceGetAttribute(&cus, hipDeviceAttributeMultiprocessorCount, dev);
        hipFuncSetAttribute((const void*)fwd_megakernel, hipFuncAttributeMaxDynamicSharedMemorySize, LDS_BYTES);
        hipOccupancyMaxActiveBlocksPerMultiprocessor(&per_cu, (const void*)fwd_megakernel, 512, LDS_BYTES);
        if (per_cu < 1) per_cu = 1;
        grid_blocks = cus * per_cu;
        fprintf(stderr, "kernel_launch: cus %d per_cu %d grid %d ws %zu need %zu\n", cus, per_cu, grid_blocks, ws_size, (size_t)WS_END);
    }
    if (grid_blocks < 0) return;
    Params p{};
    p.x = (const float*)d_in[0]; p.c = (const float*)d_in[1]; p.ctx = (const float*)d_in[2]; p.c_ctx = (const float*)d_in[3];
    p.w_mod = (const float*)d_in[4]; p.b_mod = (const float*)d_in[5]; p.norm_ffn1 = (const float*)d_in[6]; p.w13_1 = (const float*)d_in[7]; p.w2_1 = (const float*)d_in[8];
    p.norm_mix = (const float*)d_in[9]; p.w_in = (const float*)d_in[10]; p.ret_log_decay = (const float*)d_in[11]; p.w_out = (const float*)d_in[12];
    p.norm_ffn2 = (const float*)d_in[13]; p.w13_2 = (const float*)d_in[14]; p.w2_2 = (const float*)d_in[15]; p.norm_final = (const float*)d_in[16];
    p.out = (float*)d_out; p.ws = (unsigned char*)d_ws;
    void* args[] = {&p};
    hipError_t e = hipLaunchCooperativeKernel((const void*)fwd_megakernel, dim3(grid_blocks), dim3(512), args, LDS_BYTES, stream);
    if (e != hipSuccess) fprintf(stderr, "cooperative launch failed: %s (grid %d)\n", hipGetErrorString(e), grid_blocks);
}
```
